# Optimizing an MI355X kernel written in HIP

```python
import jax, jax.numpy as jnp
from jax import lax
import numpy as np

D_MODEL = 1024
BATCH = 32
SEQ = 256
DEPTH = 2
DEC_BATCH = 8
DEC_SEQ = 2048
PAST_LEN = 256

GRID_W = 64
N_MIXERS = 2
N_RET = (DEPTH + 1) // 2
N_ATTN = DEPTH // 2
RET_HEADS = 4
RET_DK = 256
RET_DV = 512
RET_CHUNK = 128
ATTN_HEADS = 16
ATTN_KV_HEADS = 4
ATTN_GROUPS = ATTN_HEADS // ATTN_KV_HEADS
HEAD_DIM = 64
WINDOW = 128
ATTN_BLOCK = 128
D_FF = 2816
CONV_WIDTH = 3
ROPE_BASE = 10000.0
EPS = 1e-6
N_MOD = 6
NEG_INF = -1e30

kernel_name = "hybrid_retention_swa_prefix_dit_step"


def rmsnorm(x, g):
    xf = x.astype(jnp.float32)
    y = xf * lax.rsqrt(jnp.mean(xf * xf, axis=-1, keepdims=True) + EPS)
    return y.astype(x.dtype) * g


def head_rms(x):
    xf = x.astype(jnp.float32)
    return (xf * lax.rsqrt(jnp.mean(xf * xf, axis=-1, keepdims=True) + EPS)).astype(x.dtype)


def adaln(cvec, w, b):
    m = jax.nn.silu(cvec) @ w + b
    return jnp.split(m, N_MOD, axis=-1)


def modulate(x, g, shift, scale):
    return rmsnorm(x, g) * (1.0 + scale) + shift


def rope_half(x, pos):
    n_freq = x.shape[-1] // 2
    inv = ROPE_BASE ** (-jnp.arange(n_freq, dtype=jnp.float32) / n_freq)
    ang = pos.astype(jnp.float32)[:, None] * inv[None, :]
    cos = jnp.cos(ang)[None, :, None, :].astype(x.dtype)
    sin = jnp.sin(ang)[None, :, None, :].astype(x.dtype)
    x1, x2 = x[..., :n_freq], x[..., n_freq:]
    return jnp.concatenate([x1 * cos - x2 * sin, x1 * sin + x2 * cos], axis=-1)


def axial_rope(x):
    L = x.shape[1]
    n_rows = L // GRID_W
    rows = jnp.repeat(jnp.arange(n_rows), GRID_W)
    cols = jnp.tile(jnp.arange(GRID_W), n_rows)
    half = x.shape[-1] // 2
    return jnp.concatenate([rope_half(x[..., :half], rows), rope_half(x[..., half:], cols)], axis=-1)


def retention_scan(q, k, v, log_gamma, s0):
    B, L, H, DK = q.shape
    DV = v.shape[-1]
    C = RET_CHUNK
    n = L // C
    idx = jnp.arange(C, dtype=jnp.float32)
    lg = log_gamma[:, None]
    diff = idx[:, None] - idx[None, :]
    dmat = jnp.where(diff >= 0, jnp.exp(lg[:, :, None] * jnp.maximum(diff, 0.0)), 0.0).astype(q.dtype)
    xi = jnp.exp(lg * (idx + 1.0)).T.astype(q.dtype)
    zeta = jnp.exp(lg * (C - 1.0 - idx)).T.astype(q.dtype)
    g_chunk = jnp.exp(log_gamma * C).astype(q.dtype)

    def to_chunks(t):
        return t.reshape(B, n, C, H, t.shape[-1]).transpose(1, 0, 2, 3, 4)

    def step(S, inp):
        qc, kc, vc = inp
        s = jnp.einsum('bihd,bjhd->bhij', qc, kc) * dmat[None]
        inner = jnp.einsum('bhij,bjhv->bihv', s, vc)
        cross = jnp.einsum('bihd,bhdv->bihv', qc, S) * xi[None, :, :, None]
        S_new = S * g_chunk[None, :, None, None] + jnp.einsum('bjhd,bjhv->bhdv', kc * zeta[None, :, :, None], vc)
        return S_new, inner + cross

    s_fin, out = lax.scan(step, s0.astype(q.dtype), (to_chunks(q), to_chunks(k), to_chunks(v)))
    return out.transpose(1, 0, 2, 3, 4).reshape(B, L, H, DV), s_fin


def retention_direction(q, k, v, log_gamma, s0, reverse):
    if reverse:
        o, s = retention_scan(q[:, ::-1], k[:, ::-1], v[:, ::-1], log_gamma, s0)
        return o[:, ::-1], s
    return retention_scan(q, k, v, log_gamma, s0)


def retention_mixer(h, wq, wk, wv, wg_f, wg_b, wo, raw_f, raw_b, s0_f, s0_b, rope):
    B, L, _ = h.shape
    q = (h @ wq).reshape(B, L, RET_HEADS, RET_DK)
    k = (h @ wk).reshape(B, L, RET_HEADS, RET_DK) * (RET_DK ** -0.5)
    v = (h @ wv).reshape(B, L, RET_HEADS, RET_DV)
    if rope:
        q, k = axial_rope(q), axial_rope(k)
    lg_f = jax.nn.log_sigmoid(raw_f.astype(jnp.float32))
    lg_b = jax.nn.log_sigmoid(raw_b.astype(jnp.float32))
    o_f, s_f = retention_direction(q, k, v, lg_f, s0_f, False)
    o_b, s_b = retention_direction(q, k, v, lg_b, s0_b, True)
    y = (head_rms(o_f).reshape(B, L, RET_HEADS * RET_DV) * jax.nn.silu(h @ wg_f)
         + head_rms(o_b).reshape(B, L, RET_HEADS * RET_DV) * jax.nn.silu(h @ wg_b))
    return y @ wo, s_f, s_b


def attn_project(h, wq, wk, wv):
    B, L, _ = h.shape
    q = (h @ wq).reshape(B, L, ATTN_HEADS, HEAD_DIM)
    k = (h @ wk).reshape(B, L, ATTN_KV_HEADS, HEAD_DIM)
    v = (h @ wv).reshape(B, L, ATTN_KV_HEADS, HEAD_DIM)
    return q, k, v


def softmax_with_sink(logits, sink):
    sink_col = jnp.broadcast_to(sink.astype(jnp.float32).reshape(ATTN_KV_HEADS, ATTN_GROUPS, 1, 1),
                                logits.shape[:-1] + (1,))
    p = jax.nn.softmax(jnp.concatenate([logits, sink_col], axis=-1), axis=-1)
    return p[..., :-1]


def context_attention(q, k, v, sink):
    B, L, H, D = q.shape
    n = L // ATTN_BLOCK
    scale = D ** -0.5
    qb = q.reshape(B, n, ATTN_BLOCK, ATTN_KV_HEADS, ATTN_GROUPS, D).transpose(1, 0, 2, 3, 4, 5)

    def block(qi):
        s = jnp.einsum('bqkgd,bskd->bkgqs', qi, k).astype(jnp.float32) * scale
        p = softmax_with_sink(s, sink).astype(v.dtype)
        return jnp.einsum('bkgqs,bskd->bqkgd', p, v)

    out = lax.map(block, qb)
    return out.transpose(1, 0, 2, 3, 4, 5).reshape(B, L, H * D)


def latent_attention(q, k, v, k_ctx, v_ctx, sink):
    B, L, H, D = q.shape
    blk = ATTN_BLOCK
    n = L // blk
    scale = D ** -0.5
    qb = q.reshape(B, n, blk, ATTN_KV_HEADS, ATTN_GROUPS, D)

    def band(t):
        z = jnp.zeros((B, blk) + t.shape[2:], t.dtype)
        tp = jnp.concatenate([z, t, z], axis=1).reshape(B, n + 2, blk, ATTN_KV_HEADS, D)
        return jnp.concatenate([tp[:, :-2], tp[:, 1:-1], tp[:, 2:]], axis=2)

    kb, vb = band(k), band(v)
    qpos = jnp.arange(L).reshape(n, blk)
    kpos = (jnp.arange(n)[:, None] - 1) * blk + jnp.arange(3 * blk)[None, :]
    rel = qpos[:, :, None] - kpos[:, None, :]
    valid = (jnp.abs(rel) <= WINDOW) & (kpos[:, None, :] >= 0) & (kpos[:, None, :] < L)
    s_band = jnp.einsum('bnqkgd,bnskd->bnkgqs', qb, kb).astype(jnp.float32) * scale
    s_band = jnp.where(valid[None, :, None, None], s_band, NEG_INF)
    s_ctx = jnp.einsum('bnqkgd,bskd->bnkgqs', qb, k_ctx).astype(jnp.float32) * scale
    p = softmax_with_sink(jnp.concatenate([s_band, s_ctx], axis=-1), sink).astype(v.dtype)
    nb = 3 * blk
    out = (jnp.einsum('bnkgqs,bnskd->bnqkgd', p[..., :nb], vb)
           + jnp.einsum('bnkgqs,bskd->bnqkgd', p[..., nb:], v_ctx))
    return out.reshape(B, L, H * D)


def conv_ffn(h, w_in, conv_w, conv_b, w_out):
    a = h @ w_in
    L = a.shape[1]
    ap = jnp.pad(a, ((0, 0), (1, 1), (0, 0)))
    a = ap[:, :L] * conv_w[0] + ap[:, 1:L + 1] * conv_w[1] + ap[:, 2:] * conv_w[2] + conv_b
    u, g = jnp.split(a, 2, axis=-1)
    return (jax.nn.silu(g) * u) @ w_out


def setup_inputs(seed: int = 0) -> dict:
    key = jax.random.key(seed)
    ks = jax.random.split(key, 40)

    def nrm(k, shape, scale=1.0):
        return jax.random.normal(k, shape, jnp.float32) * scale

    D = D_MODEL
    gamma0 = 1.0 - jnp.exp(jnp.linspace(jnp.log(1.0 / 32.0), jnp.log(1.0 / 512.0), RET_HEADS))
    raw0 = jnp.log(gamma0 / (1.0 - gamma0)).astype(jnp.float32)
    return {
        "x_prompt": nrm(ks[0], (BATCH, SEQ, D)),
        "x_sample": nrm(ks[1], (DEC_BATCH, DEC_SEQ, D)),
        "state_ret_fwd": nrm(ks[2], (DEC_BATCH, N_RET, RET_HEADS, RET_DK, RET_DV), 0.5),
        "state_ret_bwd": nrm(ks[3], (DEC_BATCH, N_RET, RET_HEADS, RET_DK, RET_DV), 0.5),
        "cache_attn_k": nrm(ks[4], (DEC_BATCH, N_ATTN, PAST_LEN, ATTN_KV_HEADS, HEAD_DIM)),
        "cache_attn_v": nrm(ks[5], (DEC_BATCH, N_ATTN, PAST_LEN, ATTN_KV_HEADS, HEAD_DIM)),
        "c": nrm(ks[6], (DEC_BATCH, D)),
        "c_ctx": nrm(ks[7], (D,)),
        "ada_w": nrm(ks[8], (DEPTH, D, N_MOD * D), D ** -0.5),
        "ada_b": nrm(ks[9], (DEPTH, N_MOD * D), 0.02),
        "norm_mix": 1.0 + nrm(ks[10], (DEPTH, D), 0.02),
        "norm_ffn": 1.0 + nrm(ks[11], (DEPTH, D), 0.02),
        "ret_wq": nrm(ks[12], (N_RET, D, RET_HEADS * RET_DK), D ** -0.5),
        "ret_wk": nrm(ks[13], (N_RET, D, RET_HEADS * RET_DK), D ** -0.5),
        "ret_wv": nrm(ks[14], (N_RET, D, RET_HEADS * RET_DV), D ** -0.5),
        "ret_wg_fwd": nrm(ks[15], (N_RET, D, RET_HEADS * RET_DV), D ** -0.5),
        "ret_wg_bwd": nrm(ks[16], (N_RET, D, RET_HEADS * RET_DV), D ** -0.5),
        "ret_wo": nrm(ks[17], (N_RET, RET_HEADS * RET_DV, D), (RET_HEADS * RET_DV) ** -0.5),
        "ret_decay_fwd": raw0[None, :] + nrm(ks[18], (N_RET, RET_HEADS), 0.01),
        "ret_decay_bwd": raw0[None, :] + nrm(ks[19], (N_RET, RET_HEADS), 0.01),
        "attn_wq": nrm(ks[20], (N_ATTN, D, ATTN_HEADS * HEAD_DIM), D ** -0.5),
        "attn_wk": nrm(ks[21], (N_ATTN, D, ATTN_KV_HEADS * HEAD_DIM), D ** -0.5),
        "attn_wv": nrm(ks[22], (N_ATTN, D, ATTN_KV_HEADS * HEAD_DIM), D ** -0.5),
        "attn_wo": nrm(ks[23], (N_ATTN, ATTN_HEADS * HEAD_DIM, D), (ATTN_HEADS * HEAD_DIM) ** -0.5),
        "attn_sink": nrm(ks[24], (N_ATTN, ATTN_HEADS), 0.5),
        "ffn_w_in": nrm(ks[25], (DEPTH, D, 2 * D_FF), D ** -0.5),
        "ffn_conv_w": nrm(ks[26], (DEPTH, CONV_WIDTH, 2 * D_FF), CONV_WIDTH ** -0.5),
        "ffn_conv_b": nrm(ks[27], (DEPTH, 2 * D_FF), 0.02),
        "ffn_w_out": nrm(ks[28], (DEPTH, D_FF, D), D_FF ** -0.5),
        "norm_final": 1.0 + nrm(ks[29], (D,), 0.02),
    }


def reference(x_prompt, x_sample, state_ret_fwd, state_ret_bwd, cache_attn_k, cache_attn_v, c, c_ctx,
              ada_w, ada_b, norm_mix, norm_ffn,
              ret_wq, ret_wk, ret_wv, ret_wg_fwd, ret_wg_bwd, ret_wo, ret_decay_fwd, ret_decay_bwd,
              attn_wq, attn_wk, attn_wv, attn_wo, attn_sink,
              ffn_w_in, ffn_conv_w, ffn_conv_b, ffn_w_out, norm_final):
    xc, xl = x_prompt, x_sample
    b_ctx = xc.shape[0]
    new_sf, new_sb, new_k, new_v = [], [], [], []
    for l in range(DEPTH):
        mc = adaln(c_ctx, ada_w[l], ada_b[l])
        ml = [t[:, None, :] for t in adaln(c, ada_w[l], ada_b[l])]
        hc = modulate(xc, norm_mix[l], mc[0], mc[1])
        hl = modulate(xl, norm_mix[l], ml[0], ml[1])
        if l % N_MIXERS == 0:
            r = l // N_MIXERS
            w = (ret_wq[r], ret_wk[r], ret_wv[r], ret_wg_fwd[r], ret_wg_bwd[r], ret_wo[r],
                 ret_decay_fwd[r], ret_decay_bwd[r])
            zero = jnp.zeros((b_ctx, RET_HEADS, RET_DK, RET_DV), xc.dtype)
            yc, s_f, s_b = retention_mixer(hc, *w, zero, zero, rope=False)
            yl, _, _ = retention_mixer(hl, *w, state_ret_fwd[:, r], state_ret_bwd[:, r], rope=True)
            new_sf.append(s_f)
            new_sb.append(s_b)
        else:
            a = l // N_MIXERS
            qc, kc, vc = attn_project(hc, attn_wq[a], attn_wk[a], attn_wv[a])
            yc = context_attention(qc, kc, vc, attn_sink[a]) @ attn_wo[a]
            ql, kl, vl = attn_project(hl, attn_wq[a], attn_wk[a], attn_wv[a])
            yl = latent_attention(axial_rope(ql), axial_rope(kl), vl,
                                  cache_attn_k[:, a], cache_attn_v[:, a], attn_sink[a]) @ attn_wo[a]
            new_k.append(kc)
            new_v.append(vc)
        xc = xc + mc[2] * yc
        xl = xl + ml[2] * yl
        hc = modulate(xc, norm_ffn[l], mc[3], mc[4])
        hl = modulate(xl, norm_ffn[l], ml[3], ml[4])
        xc = xc + mc[5] * conv_ffn(hc, ffn_w_in[l], ffn_conv_w[l], ffn_conv_b[l], ffn_w_out[l])
        xl = xl + ml[5] * conv_ffn(hl, ffn_w_in[l], ffn_conv_w[l], ffn_conv_b[l], ffn_w_out[l])
    y_prompt = rmsnorm(xc, norm_final)
    y_sample = rmsnorm(xl, norm_final)
    return (y_prompt, y_sample, jnp.stack(new_sf, axis=1), jnp.stack(new_sb, axis=1),
            jnp.stack(new_k, axis=1), jnp.stack(new_v, axis=1))
```

```cpp
#include <hip/hip_runtime.h>
#include <cstdio>
#include <cstdint>

#define LAS __attribute__((address_space(3)))
#define GAS __attribute__((address_space(1)))
typedef unsigned short bf16_t;
typedef short bf16x8 __attribute__((ext_vector_type(8)));
typedef short s16x4 __attribute__((ext_vector_type(4)));
typedef short v4i16_t __attribute__((ext_vector_type(4)));
typedef float f32x2 __attribute__((ext_vector_type(2)));
typedef float f32x4 __attribute__((ext_vector_type(4)));
typedef float f32x16 __attribute__((ext_vector_type(16)));
typedef unsigned u32x2 __attribute__((ext_vector_type(2)));
typedef unsigned u32x4 __attribute__((ext_vector_type(4)));
typedef __bf16 bf16x2_t __attribute__((ext_vector_type(2)));

constexpr int DM = 1024, NCTX = 8192, NLAT = 16384, MROWS = 24576, DFF = 2816;
constexpr float EPSV = 1e-6f;
constexpr float LOG2E = 1.4426950408889634f;

__device__ __forceinline__ unsigned cvtpk(float lo, float hi) { f32x2 v = {lo, hi}; bf16x2_t b = __builtin_convertvector(v, bf16x2_t); return __builtin_bit_cast(unsigned, b); }
__device__ __forceinline__ float bf2f(unsigned short x) { return __uint_as_float((unsigned)x << 16); }
__device__ __forceinline__ float bflo(unsigned w) { return __uint_as_float(w << 16); }
__device__ __forceinline__ float bfhi(unsigned w) { return __uint_as_float(w & 0xffff0000u); }
__device__ __forceinline__ float silu_f(float x) { return x * __builtin_amdgcn_rcpf(1.0f + __expf(-x)); }
__device__ __forceinline__ int crow(int r, int h) { return (r & 3) + 8 * (r >> 2) + 4 * h; }
#define PIN4(a, b, c, d) asm volatile("" : "+v"(a), "+v"(b), "+v"(c), "+v"(d))
#define PINV(x) asm volatile("" : "+v"(x))
#define FENCE() do { asm volatile("" ::: "memory"); __builtin_amdgcn_sched_barrier(0); } while (0)
#define MFMA32(a, b, c) __builtin_amdgcn_mfma_f32_32x32x16_bf16((a), (b), (c), 0, 0, 0)

namespace pg8 {
constexpr int BM = 256, BK = 64, HALF = 128, HTB = HALF * BK * 2, STAGE_BYTES = 8 * HTB, NXCD = 8, WGM = 8;
__host__ __device__ __forceinline__ int lds_byte(int r, int c) { const int st = (r >> 4) * 2 + (c >> 5), rr = r & 15, cc = c & 31, ob = rr * 64 + cc * 2; return st * 1024 + (ob ^ (((ob >> 9) & 1) << 5)); }
__host__ __device__ __forceinline__ void stage_rc(int b, int& R, int& C) { const int st = b / 1024, sb = b % 1024, swz = sb ^ (((sb >> 9) & 1) << 5); R = (st >> 1) * 16 + swz / 64; C = (st & 1) * 32 + (swz % 64) / 2; }
__host__ __device__ __forceinline__ int perm32(int rho) { const int n = rho >> 4, i = rho & 15; return 8 * (i >> 2) + 4 * n + (i & 3); }

struct Unit { int pm, pn, row0; };
struct Gemm { const bf16_t* A; const bf16_t* Bt; int K; };

__device__ __forceinline__ int ffn_row0(int pm) {
    if (pm < 32) return pm * 256;
    const int p = pm - 32, b = p / 9, k = p - 9 * b; const int s = 254 * k; return NCTX + b * 2048 + (s > 1792 ? 1792 : s);
}
struct TileOrder {
    int nM, nN, nwg, G, c, ffn;
    __device__ __forceinline__ void init(int nM_, int nN_, int G_, int c_, int ffn_) { nM = nM_; nN = nN_; nwg = nM * nN; G = G_; c = c_; ffn = ffn_; }
    __device__ __forceinline__ bool next(int i, Unit& u) const {
        const long L = (long)i * G + c; if (L >= nwg) return false;
        int wgid = (int)L; { const int q = nwg / NXCD, r = nwg % NXCD, xcd = wgid % NXCD, off = wgid / NXCD; wgid = (xcd < r ? xcd * (q + 1) : r * (q + 1) + (xcd - r) * q) + off; }
        const int nig = WGM * nN, gid = wgid / nig, fm = gid * WGM, gsz = (nM - fm) < WGM ? (nM - fm) : WGM;
        u.pm = fm + ((wgid % nig) % gsz); u.pn = (wgid % nig) / gsz;
        u.row0 = ffn ? ffn_row0(u.pm) : u.pm * BM; return true;
    }
};


struct EpiRet {
    static constexpr bool PERM = true;
    bf16_t *q, *k, *v, *sgf, *sgb; const float* tab;
    __device__ __forceinline__ void operator()(const f32x4 (&acc)[2][2][4][2], const Unit& u, int wr, int wc, int fr, int fq) const {
        const int pn = u.pn; const int rbase = u.row0 + wr * 64 + fr;
        if (pn < 8) {
            const bool isk = pn >= 4; bf16_t* dst = (isk ? k : q) + (pn & 3) * 256; const float sc = isk ? 0.0625f : 1.0f;
            const bool lat = u.row0 >= NCTX; const int i0 = 4 * (4 * wc + fq);
#pragma unroll
            for (int ai = 0; ai < 2; ++ai)
#pragma unroll
                for (int m = 0; m < 4; ++m) { const int r = rbase + ai * HALF + m * 16; const int s = (r - NCTX) & 2047;
                    f32x4 av[2][2] = {{acc[ai][0][m][0], acc[ai][0][m][1]}, {acc[ai][1][m][0], acc[ai][1][m][1]}}; PIN4(av[0][0], av[0][1], av[1][0], av[1][1]);
#pragma unroll
                    for (int bj = 0; bj < 2; ++bj) { const int pos = bj ? (s & 63) : (s >> 6);
                        f32x4 x1 = av[bj][0] * sc, x2 = av[bj][1] * sc, o1 = x1, o2 = x2;
                        if (lat) { const f32x4* tp = (const f32x4*)(tab + (pos * 64 + i0) * 2); const f32x4 t0 = tp[0], t1 = tp[1];
                            const f32x4 cs = {t0[0], t0[2], t1[0], t1[2]}, sn = {t0[1], t0[3], t1[1], t1[3]};
                            o1 = x1 * cs - x2 * sn; o2 = x1 * sn + x2 * cs; }
                        bf16_t* p = dst + (size_t)r * 1024 + 128 * bj + i0;
                        u32x2 w1 = {cvtpk(o1[0], o1[1]), cvtpk(o1[2], o1[3])}, w2 = {cvtpk(o2[0], o2[1]), cvtpk(o2[2], o2[3])};
                        *(u32x2*)p = w1; *(u32x2*)(p + 64) = w2; }
                    asm volatile("" ::: "memory"); }
        } else if (pn < 16) { store_plain(acc, v, (pn - 8) * 256, false, rbase, wc, fq); }
        else if (pn < 24) { store_plain(acc, sgf, (pn - 16) * 256, true, rbase, wc, fq); }
        else { store_plain(acc, sgb, (pn - 24) * 256, true, rbase, wc, fq); }
    }
    __device__ __forceinline__ void store_plain(const f32x4 (&acc)[2][2][4][2], bf16_t* dst, int col0, bool act, int rbase, int wc, int fq) const {
        const int col = col0 + wc * 32 + 8 * fq;
#pragma unroll
        for (int ai = 0; ai < 2; ++ai)
#pragma unroll
            for (int m = 0; m < 4; ++m) { bf16_t* rowp = dst + (size_t)(rbase + ai * HALF + m * 16) * 2048 + col;
                f32x4 av[2][2] = {{acc[ai][0][m][0], acc[ai][0][m][1]}, {acc[ai][1][m][0], acc[ai][1][m][1]}}; PIN4(av[0][0], av[0][1], av[1][0], av[1][1]);
#pragma unroll
                for (int bj = 0; bj < 2; ++bj) { f32x4 v0 = av[bj][0], v1 = av[bj][1];
                    if (act) { for (int j = 0; j < 4; ++j) { v0[j] = silu_f(v0[j]); v1[j] = silu_f(v1[j]); } }
                    u32x4 w; w.x = cvtpk(v0[0], v0[1]); w.y = cvtpk(v0[2], v0[3]); w.z = cvtpk(v1[0], v1[1]); w.w = cvtpk(v1[2], v1[3]);
                    *(u32x4*)(rowp + bj * HALF) = w; }
                asm volatile("" ::: "memory"); }
    }
};

struct EpiResid {
    static constexpr bool PERM = false;
    const float* xa; const float* xb; float* xo; const float* gate;
    __device__ __forceinline__ void operator()(const f32x4 (&acc)[2][2][4][2], const Unit& u, int wr, int wc, int fr, int fq) const {
        const int col0 = u.pn * BM + wc * 32 + 4 * fq; const int mb = u.row0 < NCTX ? 8 : ((u.row0 - NCTX) >> 11);
        const float* xin = u.row0 < NCTX ? xa + (size_t)u.row0 * 1024 : xb + (size_t)(u.row0 - NCTX) * 1024;
        float* xout = xo + (size_t)u.row0 * 1024; const float* gp = gate + mb * 6144 + col0;
        f32x4 gv[2][2];
#pragma unroll
        for (int bj = 0; bj < 2; ++bj)
#pragma unroll
            for (int n = 0; n < 2; ++n) gv[bj][n] = *(const f32x4*)(gp + bj * HALF + n * 16);
#pragma unroll
        for (int ai = 0; ai < 2; ++ai)
#pragma unroll
            for (int m = 0; m < 4; ++m) { const size_t off = (size_t)(ai * HALF + wr * 64 + m * 16 + fr) * 1024 + col0;
                f32x4 av[2][2] = {{acc[ai][0][m][0], acc[ai][0][m][1]}, {acc[ai][1][m][0], acc[ai][1][m][1]}}; PIN4(av[0][0], av[0][1], av[1][0], av[1][1]);
#pragma unroll
                for (int bj = 0; bj < 2; ++bj)
#pragma unroll
                    for (int n = 0; n < 2; ++n) { const f32x4 bs = *(const f32x4*)(xin + off + bj * HALF + n * 16);
                        *(f32x4*)(xout + off + bj * HALF + n * 16) = bs + gv[bj][n] * av[bj][n]; }
                asm volatile("" ::: "memory"); }
    }
};

struct EpiAttnQKV {
    static constexpr bool PERM = true;
    bf16_t *q, *k, *v; float *ok, *ov; const float* tab;
    __device__ __forceinline__ void operator()(const f32x4 (&acc)[2][2][4][2], const Unit& u, int wr, int wc, int fr, int fq) const {
        const int pn = u.pn; const int rbase = u.row0 + wr * 64 + fr; const bool lat = u.row0 >= NCTX;
        if (pn < 5) {
            const bool isk = pn == 4; const float sc = isk ? 1.0f : 0.125f * LOG2E; const int half = wc & 1, i0 = 4 * fq;
#pragma unroll
            for (int ai = 0; ai < 2; ++ai)
#pragma unroll
                for (int m = 0; m < 4; ++m) { const int r = rbase + ai * HALF + m * 16; const int s = (r - NCTX) & 2047; const int pos = half ? (s & 63) : (s >> 6);
                    f32x4 av[2][2] = {{acc[ai][0][m][0], acc[ai][0][m][1]}, {acc[ai][1][m][0], acc[ai][1][m][1]}}; PIN4(av[0][0], av[0][1], av[1][0], av[1][1]);
                    f32x4 cs = {1.f, 1.f, 1.f, 1.f}, sn = {0.f, 0.f, 0.f, 0.f};
                    if (lat) { const f32x4* tp = (const f32x4*)(tab + (pos * 16 + i0) * 2); const f32x4 t0 = tp[0], t1 = tp[1];
                        cs = (f32x4){t0[0], t0[2], t1[0], t1[2]}; sn = (f32x4){t0[1], t0[3], t1[1], t1[3]}; }
#pragma unroll
                    for (int bj = 0; bj < 2; ++bj) { const int hh = 2 * bj + (wc >> 1);
                        const f32x4 x1 = av[bj][0], x2 = av[bj][1];
                        const f32x4 o1 = (x1 * cs - x2 * sn) * sc, o2 = (x1 * sn + x2 * cs) * sc;
                        const int t1c = 32 * half + i0;
                        bf16_t* p = isk ? k + (size_t)r * 256 + hh * 64 + t1c : q + (size_t)r * 1024 + (pn * 4 + hh) * 64 + t1c;
                        u32x2 w1 = {cvtpk(o1[0], o1[1]), cvtpk(o1[2], o1[3])}, w2 = {cvtpk(o2[0], o2[1]), cvtpk(o2[2], o2[3])};
                        *(u32x2*)p = w1; *(u32x2*)(p + 16) = w2;
                        if (isk && !lat) { float* o = ok + (size_t)r * 256 + hh * 64 + t1c; *(f32x4*)o = x1; *(f32x4*)(o + 16) = x2; } }
                    asm volatile("" ::: "memory"); }
        } else {
            const int col = wc * 32 + 8 * fq;
#pragma unroll
            for (int ai = 0; ai < 2; ++ai)
#pragma unroll
                for (int m = 0; m < 4; ++m) { const int r = rbase + ai * HALF + m * 16;
                    f32x4 av[2][2] = {{acc[ai][0][m][0], acc[ai][0][m][1]}, {acc[ai][1][m][0], acc[ai][1][m][1]}}; PIN4(av[0][0], av[0][1], av[1][0], av[1][1]);
#pragma unroll
                    for (int bj = 0; bj < 2; ++bj) { const f32x4 v0 = av[bj][0], v1 = av[bj][1];
                        u32x4 w; w.x = cvtpk(v0[0], v0[1]); w.y = cvtpk(v0[2], v0[3]); w.z = cvtpk(v1[0], v1[1]); w.w = cvtpk(v1[2], v1[3]);
                        *(u32x4*)(v + (size_t)r * 256 + col + bj * HALF) = w;
                        if (!lat) { float* o = ov + (size_t)r * 256 + col + bj * HALF; *(f32x4*)o = v0; *(f32x4*)(o + 4) = v1; } }
                    asm volatile("" ::: "memory"); }
        }
    }
};

struct EpiFfn {
    static constexpr bool PERM = true;
    bf16_t* act; const float* cw; const float* cb; LAS float* xch;
    __device__ __forceinline__ void operator()(const f32x4 (&acc)[2][2][4][2], const Unit& u, int wr, int wc, int fr, int fq) const {
        const int lane = 16 * fq + fr;
        int lo = 0, hi = 256;
        if (u.pm >= 32) { const int k = (u.pm - 32) % 9; if (k == 0) { hi = 255; } else if (k < 8) { lo = 1; hi = 255; } else { lo = 241; hi = 256; } }
#pragma unroll
        for (int ai = 0; ai < 2; ++ai)
#pragma unroll
            for (int bj = 0; bj < 2; ++bj) {
                if (fr == 0) { LAS f32x4* p = (LAS f32x4*)xch + ((((ai * 2 + wr) * 2 + 0) * 4 + wc) * 4 + fq) * 4 + bj * 2; p[0] = acc[ai][bj][0][0]; p[1] = acc[ai][bj][0][1]; }
                if (fr == 15) { LAS f32x4* p = (LAS f32x4*)xch + ((((ai * 2 + wr) * 2 + 1) * 4 + wc) * 4 + fq) * 4 + bj * 2; p[0] = acc[ai][bj][3][0]; p[1] = acc[ai][bj][3][1]; }
            }
        asm volatile("s_waitcnt lgkmcnt(0)" ::: "memory"); __builtin_amdgcn_s_barrier(); asm volatile("" ::: "memory");
        const int lprev = (lane & 48) | ((fr + 15) & 15), lnext = (lane & 48) | ((fr + 1) & 15);
#pragma unroll
        for (int bj = 0; bj < 2; ++bj) {
            const int c0 = u.pn * 128 + 64 * bj + 16 * wc + 4 * fq;
            const f32x4 wu0 = *(const f32x4*)(cw + c0), wu1 = *(const f32x4*)(cw + 5632 + c0), wu2 = *(const f32x4*)(cw + 2 * 5632 + c0), bu = *(const f32x4*)(cb + c0);
            const f32x4 wg0 = *(const f32x4*)(cw + DFF + c0), wg1 = *(const f32x4*)(cw + 5632 + DFF + c0), wg2 = *(const f32x4*)(cw + 2 * 5632 + DFF + c0), bg = *(const f32x4*)(cb + DFF + c0);
#pragma unroll
            for (int ai = 0; ai < 2; ++ai) {
                f32x4 pu = {0.f, 0.f, 0.f, 0.f}, pg = pu, nu = pu, ng = pu;
                { int pai = ai, pwr = wr - 1; if (pwr < 0) { pwr = 1; pai = ai - 1; }
                  if (pai >= 0) { const LAS f32x4* p = (const LAS f32x4*)xch + ((((pai * 2 + pwr) * 2 + 1) * 4 + wc) * 4 + fq) * 4 + bj * 2; pu = p[0]; pg = p[1]; }
                  int nai = ai, nwr = wr + 1; if (nwr > 1) { nwr = 0; nai = ai + 1; }
                  if (nai < 2) { const LAS f32x4* p = (const LAS f32x4*)xch + ((((nai * 2 + nwr) * 2 + 0) * 4 + wc) * 4 + fq) * 4 + bj * 2; nu = p[0]; ng = p[1]; } }
#pragma unroll
                for (int m = 0; m < 4; ++m) {
                    f32x4 uc = acc[ai][bj][m][0], gc = acc[ai][bj][m][1];
                    f32x4 sp_u = (m > 0 && fr == 15) ? acc[ai][bj][m > 0 ? m - 1 : 0][0] : uc, sp_g = (m > 0 && fr == 15) ? acc[ai][bj][m > 0 ? m - 1 : 0][1] : gc;
                    f32x4 sn_u = (m < 3 && fr == 0) ? acc[ai][bj][m < 3 ? m + 1 : 3][0] : uc, sn_g = (m < 3 && fr == 0) ? acc[ai][bj][m < 3 ? m + 1 : 3][1] : gc;
                    PIN4(uc, gc, sp_u, sp_g); PIN4(sn_u, sn_g, uc, gc);
                    f32x4 up, gp, un, gn;
#pragma unroll
                    for (int j = 0; j < 4; ++j) { up[j] = __shfl(sp_u[j], lprev); gp[j] = __shfl(sp_g[j], lprev); un[j] = __shfl(sn_u[j], lnext); gn[j] = __shfl(sn_g[j], lnext); }
                    if (m == 0 && fr == 0) { up = pu; gp = pg; }
                    if (m == 3 && fr == 15) { un = nu; gn = ng; }
                    const f32x4 uu = wu0 * up + wu1 * uc + wu2 * un + bu;
                    const f32x4 gg = wg0 * gp + wg1 * gc + wg2 * gn + bg;
                    const int lr = ai * HALF + wr * 64 + m * 16 + fr;
                    if (lr >= lo && lr < hi) { u32x2 w = {cvtpk(silu_f(gg[0]) * uu[0], silu_f(gg[1]) * uu[1]), cvtpk(silu_f(gg[2]) * uu[2], silu_f(gg[3]) * uu[3])};
                        *(u32x2*)(act + (size_t)(u.row0 + lr) * DFF + c0) = w; }
                    asm volatile("" ::: "memory");
                }
            }
        }
        asm volatile("s_waitcnt lgkmcnt(0)" ::: "memory"); __builtin_amdgcn_s_barrier(); asm volatile("" ::: "memory");
    }
};

template <class Epi, class Sched>
__device__ __forceinline__ void gemm_phase(LAS unsigned char* lds, const Gemm g, const Sched& S, const Epi& E) {
    int tid_ = threadIdx.x; asm volatile("" : "+v"(tid_));
    const int tid = tid_, wid = __builtin_amdgcn_readfirstlane(tid >> 6), lane = tid & 63, wr = wid >> 2, wc = wid & 3, fr = lane & 15, fq = lane >> 4;
    const int K = g.K, nt = K / BK;
    unsigned voffA[2], voffB[2];
#pragma unroll
    for (int i = 0; i < 2; ++i) { int R, C; stage_rc(tid * 16 + i * 8192, R, C); const int Rb = Epi::PERM ? ((R & ~31) + perm32(R & 31)) : R;
        voffA[i] = (unsigned)(R * K + C) * 2u; voffB[i] = (unsigned)(Rb * K + C) * 2u; }
    const size_t kstep = (size_t)(BK * 2);
    const size_t hstep = (size_t)HALF * K * 2;
    const size_t tstep = 2 * hstep;
    const size_t rstep = (size_t)K * 2;
    const unsigned ldsw = (unsigned)wid * 1024u;
    const int aoff = lds_byte(wr * 64 + fr, fq * 8), boff = lds_byte(wc * 32 + fr, fq * 8);
#define PG8_SA(b, h) (((b) * 2 + (h)) * HTB)
#define PG8_SB(b, h) ((4 + (b) * 2 + (h)) * HTB)
#define PG8_STAGE(bufoff, gbase, voff) do { _Pragma("unroll") for (int _i = 0; _i < 2; ++_i) \
        __builtin_amdgcn_global_load_lds((const unsigned*)((const char*)(gbase) + (voff)[_i]), (LAS unsigned*)(lds + (bufoff) + ldsw + _i * 8192), 16, 0, 0); } while (0)
#define PG8_LDA(dst, b, h) do { _Pragma("unroll") for (int m = 0; m < 4; ++m) _Pragma("unroll") for (int k = 0; k < 2; ++k) dst[m][k] = *(const LAS bf16x8*)(lds + PG8_SA(b, h) + aoff + m * 2048 + k * 1024); } while (0)
#define PG8_LDB(dst, b, h) do { _Pragma("unroll") for (int n = 0; n < 2; ++n) _Pragma("unroll") for (int k = 0; k < 2; ++k) dst[n][k] = *(const LAS bf16x8*)(lds + PG8_SB(b, h) + boff + n * 2048 + k * 1024); } while (0)
#define PG8_MMA(ai, bj, At, Bt) do { __builtin_amdgcn_s_setprio(1); _Pragma("unroll") for (int m = 0; m < 4; ++m) _Pragma("unroll") for (int n = 0; n < 2; ++n) _Pragma("unroll") for (int k = 0; k < 2; ++k) \
        acc[ai][bj][m][n] = __builtin_amdgcn_mfma_f32_16x16x32_bf16(Bt[n][k], At[m][k], acc[ai][bj][m][n], 0, 0, 0); __builtin_amdgcn_s_setprio(0); } while (0)
#define PG8_WAIT_V(n) asm volatile("s_waitcnt vmcnt(" #n ")" ::: "memory")
#define PG8_WAIT_L(n) asm volatile("s_waitcnt lgkmcnt(" #n ")" ::: "memory")
#define PG8_BAR __builtin_amdgcn_s_barrier()
#define PG8_SCHED __builtin_amdgcn_sched_barrier(0)
    Unit cur, nxt; int ui = 0;
    if (!S.next(0, cur)) return;
    f32x4 acc[2][2][4][2];
#pragma unroll
    for (int a = 0; a < 2; ++a)
#pragma unroll
        for (int b = 0; b < 2; ++b)
#pragma unroll
            for (int m = 0; m < 4; ++m)
#pragma unroll
                for (int n = 0; n < 2; ++n) acc[a][b][m][n] = (f32x4){0.f, 0.f, 0.f, 0.f};
    bf16x8 At[4][2], B0[2][2], B1[2][2];
    const char* cA = (const char*)g.A + (size_t)cur.row0 * rstep; const char* cB = (const char*)g.Bt + (size_t)cur.pn * tstep;
    PG8_STAGE(PG8_SB(0, 0), cB, voffB); PG8_STAGE(PG8_SB(0, 1), cB + hstep, voffB); PG8_STAGE(PG8_SA(0, 0), cA, voffA); PG8_STAGE(PG8_SA(0, 1), cA + hstep, voffA);
    if (wr == 1) PG8_BAR;
    PG8_WAIT_V(2); PG8_BAR;
    PG8_STAGE(PG8_SB(1, 0), cB + kstep, voffB); PG8_STAGE(PG8_SA(1, 0), cA + kstep, voffA); PG8_STAGE(PG8_SB(1, 1), cB + hstep + kstep, voffB);
    PG8_WAIT_V(6); PG8_BAR;
    for (;;) {
        const bool has_next = S.next(ui + 1, nxt);
        const char* nA = has_next ? (const char*)g.A + (size_t)nxt.row0 * rstep : cA; const char* nB = has_next ? (const char*)g.Bt + (size_t)nxt.pn * tstep : cB;
        for (int t = 0; t < nt; t += 2) {
            const bool last = (t == nt - 2);
            const char* a1 = cA + (size_t)(t + 1) * kstep;
            const char* a2 = last ? nA : cA + (size_t)(t + 2) * kstep; const char* b2 = last ? nB : cB + (size_t)(t + 2) * kstep;
            const char* a3 = a2 + kstep; const char* b3 = b2 + kstep;
            PG8_LDB(B0, 0, 0); PG8_LDB(B1, 0, 1); PG8_SCHED; PG8_LDA(At, 0, 0); PG8_STAGE(PG8_SA(1, 1), a1 + hstep, voffA);
            PG8_WAIT_V(8); PG8_WAIT_L(0); PG8_BAR; PG8_MMA(0, 0, At, B0); PG8_MMA(0, 1, At, B1); PG8_BAR; PG8_SCHED;
            PG8_LDA(At, 0, 1); PG8_STAGE(PG8_SB(0, 0), b2, voffB); PG8_STAGE(PG8_SB(0, 1), b2 + hstep, voffB); PG8_STAGE(PG8_SA(0, 0), a2, voffA);
            PG8_WAIT_V(8); PG8_WAIT_L(0); PG8_BAR; PG8_MMA(1, 0, At, B0); PG8_MMA(1, 1, At, B1); PG8_BAR; PG8_SCHED;
            PG8_LDB(B0, 1, 0); PG8_LDB(B1, 1, 1); PG8_SCHED; PG8_LDA(At, 1, 0); PG8_STAGE(PG8_SA(0, 1), a2 + hstep, voffA);
            PG8_WAIT_V(8); PG8_WAIT_L(0); PG8_BAR; PG8_MMA(0, 0, At, B0); PG8_MMA(0, 1, At, B1); PG8_BAR; PG8_SCHED;
            PG8_LDA(At, 1, 1); PG8_STAGE(PG8_SB(1, 0), b3, voffB); PG8_STAGE(PG8_SB(1, 1), b3 + hstep, voffB); PG8_STAGE(PG8_SA(1, 0), a3, voffA);
            PG8_WAIT_V(8); PG8_WAIT_L(0); PG8_BAR; PG8_MMA(1, 0, At, B0); PG8_MMA(1, 1, At, B1); PG8_BAR; PG8_SCHED;
        }
        if (wr == 0) PG8_BAR;
        { int l2 = lane; asm volatile("" : "+v"(l2)); E(acc, cur, wr, wc, l2 & 15, l2 >> 4); }
        if (!has_next) break;
#pragma unroll
        for (int a = 0; a < 2; ++a)
#pragma unroll
            for (int b = 0; b < 2; ++b)
#pragma unroll
                for (int m = 0; m < 4; ++m)
#pragma unroll
                    for (int n = 0; n < 2; ++n) acc[a][b][m][n] = (f32x4){0.f, 0.f, 0.f, 0.f};
        cur = nxt; cA = nA; cB = nB; ++ui;
        if (wr == 1) PG8_BAR;
    }
    PG8_WAIT_V(0);
    PG8_BAR;
#undef PG8_SA
#undef PG8_SB
#undef PG8_STAGE
#undef PG8_LDA
#undef PG8_LDB
#undef PG8_MMA
#undef PG8_WAIT_V
#undef PG8_WAIT_L
#undef PG8_BAR
#undef PG8_SCHED
}
}

constexpr int NWAVES = 8;
constexpr size_t MiB = 1u << 20;
constexpr size_t CTL_BYTES = 2 * MiB;
constexpr size_t CTL_BAR_B = 16384, CTL_MOD_B = 65536, CTL_STATS_B = 524288;
constexpr size_t WS_TABR = 2 * MiB, WS_TABA = 2 * MiB + 65536;
constexpr size_t WS_CK = 3 * MiB, WS_CV = 4 * MiB;
constexpr size_t WS_Q = 8 * MiB, WS_K = 56 * MiB, WS_V = 104 * MiB, WS_SGF = 200 * MiB, WS_NEED = 296 * MiB;
constexpr size_t WS_Y = 8 * MiB;
constexpr size_t WS_WO_RET = 104 * MiB, WS_WIN0 = 108 * MiB, WS_WIN1 = 119 * MiB, WS_WOUT0 = 130 * MiB, WS_WOUT1 = 135 * MiB + 512 * 1024,
                 WS_WQKV = 141 * MiB, WS_WOA = 144 * MiB;
constexpr size_t WS_H = 8 * MiB;
constexpr size_t WS_ACT = 160 * MiB;
constexpr size_t WS_AQ = 56 * MiB, WS_AK = 146 * MiB, WS_AV = 158 * MiB, WS_AO = 200 * MiB;
constexpr size_t OUT_SGB = 0;
constexpr size_t OUT_H0 = 96 * MiB, OUT_W1T = 144 * MiB;
constexpr size_t OUT_SF = (size_t)25165824 * 4, OUT_SB = (size_t)41943040 * 4, OUT_NK = (size_t)58720256 * 4, OUT_NV = (size_t)60817408 * 4;
constexpr int RING_BYTES = 131072, XCH_OFF = 131072, LDSCTL_OFF = 147456, MISC_OFF = LDSCTL_OFF + 320, INTAB_OFF = LDSCTL_OFF + 512, LDS_BYTES = 151552;

typedef GAS unsigned gu32;
#define RLX_AGENT __ATOMIC_RELAXED, __HIP_MEMORY_SCOPE_AGENT
#define PHASE_IDS() int tid_ = threadIdx.x; asm volatile("" : "+v"(tid_)); const int tid = tid_, lane = tid & 63, wid = __builtin_amdgcn_readfirstlane(tid >> 6); (void)tid; (void)lane; (void)wid; (void)0

#define XB_TMO      128
#define XB_XCNT(j)  (256  + 64 * (j))
#define XB_XSUB(j)  (1280 + 64 * (j))
#define XB_XGEN(j)  (2304 + 64 * (j))
#define XB_TOP      3328
#define XB_TOPGEN   3392
#define XCD_BAR_WORDS 3456
#define XB_SPIN_CAP (1u << 27)
__device__ __forceinline__ unsigned xb_ld(unsigned* p)              { return __hip_atomic_load(p, __ATOMIC_RELAXED, __HIP_MEMORY_SCOPE_AGENT); }
__device__ __forceinline__ unsigned xb_add(unsigned* p, unsigned v) { return __hip_atomic_fetch_add(p, v, __ATOMIC_RELAXED, __HIP_MEMORY_SCOPE_AGENT); }
__device__ __forceinline__ unsigned xb_xcc_id() { return (unsigned)__builtin_amdgcn_s_getreg((3 << 11) | 20) & 0xFu; }
#define XB_SPIN(cond, bar) do { unsigned _sp = 0; while (cond) { __builtin_amdgcn_s_sleep(1); \
    if ((++_sp & 255u) == 0u) { if (xb_ld(&(bar)[XB_TMO])) break; if (_sp > XB_SPIN_CAP) { atomicAdd(&(bar)[XB_TMO], 1u); break; } } } } while (0)
struct XcdBarrier { unsigned* bar; unsigned x; volatile LAS unsigned* st; };
__device__ __forceinline__ XcdBarrier xcd_barrier_post(unsigned* bar, volatile LAS unsigned* st) {
    XcdBarrier b; b.bar = bar; b.x = (unsigned)__builtin_amdgcn_readfirstlane((int)xb_xcc_id()); b.st = st;
    if (threadIdx.x == 0) (void)xb_add(&bar[XB_XCNT(b.x)], 1u);
    return b;
}
__device__ __forceinline__ void xcd_barrier_complete(unsigned* bar, unsigned x, unsigned& nloc, unsigned& nx) {
    const unsigned G = gridDim.x * gridDim.y * gridDim.z;
    unsigned sum, cnt, mine, sp = 0u;
    for (;;) {
        sum = 0u; cnt = 0u; mine = 0u;
#pragma unroll
        for (unsigned j = 0; j < 16; ++j) { const unsigned c = xb_ld(&bar[XB_XCNT(j)]); sum += c; cnt += (c > 0u) ? 1u : 0u; }
        if (sum == G) { mine = xb_ld(&bar[XB_XCNT(x)]); break; }
        __builtin_amdgcn_s_sleep(1);
        if ((++sp & 255u) == 0u) { if (xb_ld(&bar[XB_TMO])) break; if (sp > XB_SPIN_CAP) { atomicAdd(&bar[XB_TMO], 1u); break; } }
    }
    nloc = mine > 0u ? mine : 1u; nx = cnt > 0u ? cnt : 1u;
}
__device__ __forceinline__ void xcd_barrier(const XcdBarrier& b) {
    asm volatile("s_waitcnt vmcnt(0)" ::: "memory");
    __syncthreads();
    if (threadIdx.x == 0) {
        unsigned* bar = b.bar; unsigned bxx = b.x; asm volatile("" : "+s"(bar), "+s"(bxx));
        __builtin_amdgcn_s_waitcnt(0);
        unsigned nloc = b.st[0], nx = b.st[1];
        if (nloc == 0u) { xcd_barrier_complete(bar, bxx, nloc, nx); b.st[0] = nloc; b.st[1] = nx; }
        const unsigned old = xb_add(&bar[XB_XSUB(bxx)], 1u);
        const unsigned gen = old / nloc;
        if (old + 1u == (gen + 1u) * nloc) {
            __builtin_amdgcn_fence(__ATOMIC_RELEASE, "agent");
            asm volatile("s_waitcnt vmcnt(0)" ::: "memory");
            const unsigned og = xb_add(&bar[XB_TOP], 1u);
            const unsigned tg = og / nx;
            if (og + 1u == (tg + 1u) * nx) xb_add(&bar[XB_TOPGEN], 1u);
            else XB_SPIN(xb_ld(&bar[XB_TOPGEN]) == tg, bar);
            __builtin_amdgcn_fence(__ATOMIC_ACQUIRE, "agent");
            xb_add(&bar[XB_XGEN(bxx)], 1u);
            asm volatile("s_waitcnt vmcnt(0)" ::: "memory");
        } else {
            XB_SPIN(xb_ld(&bar[XB_XGEN(bxx)]) == gen, bar);
            __builtin_amdgcn_fence(__ATOMIC_ACQUIRE, "agent");
            asm volatile("s_waitcnt vmcnt(0)" ::: "memory");
        }
    }
    __syncthreads();
}

struct Args { const float* in[30]; float* out; unsigned char* ws; };
struct Frame {
    LAS unsigned char* lds; int vcu, G; float* out; unsigned char* ws; unsigned char* ob;
};
__device__ __forceinline__ const float* inp(const Frame& F, int i) {
    const LAS unsigned* t = (const LAS unsigned*)(F.lds + INTAB_OFF) + 2 * i; const unsigned lo = __builtin_amdgcn_readfirstlane(t[0]), hi = __builtin_amdgcn_readfirstlane(t[1]);
    return (const float*)(((unsigned long long)hi << 32) | lo); }
__device__ __forceinline__ float wave_sum(float v) {
#pragma unroll
    for (int o = 1; o < 64; o <<= 1) v += __shfl_xor(v, o);
    return v;
}

__device__ __forceinline__ int rowmap(int mode, int t) {
    if (mode == 1) { const int th = t & 255, half = th >> 7, w = th & 127, i = w & 63, hi = w >> 6; return (t & ~255) + 8 * ((half << 4) + (i >> 2)) + 4 * hi + (i & 3); }
    if (mode == 2) { const int th = t & 63, half = th >> 5, w = th & 31, i = w & 15, hi = w >> 4; return (t & ~63) + 8 * ((half << 2) + (i >> 2)) + 4 * hi + (i & 3); }
    if (mode == 3) { const int isg = t >= DFF ? 1 : 0; const int tt = isg ? t - DFF : t; return 8 * (tt >> 2) + 4 * isg + (tt & 3); }
    return t;
}
__device__ __forceinline__ void transpose_item(const float* W, int K, int N, bf16_t* WT, int row_off, int mode, LAS float* scr, int item, int lane) {
    const int nblk = N / 32, kb = item / nblk, nb = item % nblk, k0 = 64 * kb, n0 = 32 * nb;
#pragma unroll 8
    for (int i = 0; i < 32; ++i) { const int kk = 2 * i + (lane >> 5); scr[kk * 33 + (lane & 31)] = W[(size_t)(k0 + kk) * N + n0 + (lane & 31)]; }
    asm volatile("s_waitcnt lgkmcnt(0)" ::: "memory");
    const int c = lane & 7;
#pragma unroll
    for (int j = 0; j < 4; ++j) { const int n = (lane >> 3) + 8 * j; const LAS float* s = scr + (8 * c) * 33 + n;
        u32x4 o; o.x = cvtpk(s[0 * 33], s[1 * 33]); o.y = cvtpk(s[2 * 33], s[3 * 33]); o.z = cvtpk(s[4 * 33], s[5 * 33]); o.w = cvtpk(s[6 * 33], s[7 * 33]);
        *(u32x4*)(WT + (size_t)(row_off + rowmap(mode, n0 + n)) * K + k0 + 8 * c) = o; }
    asm volatile("s_waitcnt lgkmcnt(0)" ::: "memory");
}
struct TrJob { const float* W; int K, N; bf16_t* WT; int row_off, mode, nitems; };
template <int NJ> __device__ __forceinline__ void run_transposes(const TrJob (&jobs)[NJ], LAS float* scr, int gw, int NGW, int lane) {
    int total = 0;
#pragma unroll
    for (int j = 0; j < NJ; ++j) total += jobs[j].nitems;
    for (int it = gw; it < total; it += NGW) {
        int r = it;
#pragma unroll
        for (int j = 0; j < NJ; ++j) { if (r >= 0 && r < jobs[j].nitems) { transpose_item(jobs[j].W, jobs[j].K, jobs[j].N, jobs[j].WT, jobs[j].row_off, jobs[j].mode, scr, r, lane); } r -= jobs[j].nitems; }
    }
}

__device__ __forceinline__ void p0_prologue(Frame& F) {
    PHASE_IDS();
    LAS float* scr = (LAS float*)(F.lds + wid * 16384);
    const int gw = F.vcu * NWAVES + wid, NGW = F.G * NWAVES;
    float* mod = (float*)(F.ws + CTL_MOD_B);
    for (int it = gw; it < 192; it += NGW) {
        const int l = it / 96, j0 = (it % 96) * 64; const float* W = inp(F, 8) + (size_t)l * 1024 * 6144 + j0 + lane;
        float acc[9]; const float bias = inp(F, 9)[l * 6144 + j0 + lane];
#pragma unroll
        for (int mb = 0; mb < 9; ++mb) acc[mb] = bias;
        for (int kb = 0; kb < 16; ++kb) {
            float sreg[9];
#pragma unroll
            for (int mb = 0; mb < 9; ++mb) { const float cv = mb < 8 ? inp(F, 6)[mb * 1024 + kb * 64 + lane] : inp(F, 7)[kb * 64 + lane]; sreg[mb] = cv / (1.0f + expf(-cv)); }
#pragma unroll 16
            for (int kk = 0; kk < 64; ++kk) { const float wv = W[(size_t)(kb * 64 + kk) * 6144];
#pragma unroll
                for (int mb = 0; mb < 9; ++mb) acc[mb] += __uint_as_float(__builtin_amdgcn_readlane(__float_as_uint(sreg[mb]), kk)) * wv; }
        }
#pragma unroll
        for (int mb = 0; mb < 9; ++mb) mod[(l * 9 + mb) * 6144 + j0 + lane] = acc[mb];
    }
    { float* tr = (float*)(F.ws + WS_TABR); float* ta = (float*)(F.ws + WS_TABA);
      for (int e = gw * 64 + lane; e < 4096 + 1024; e += NGW * 64) {
          if (e < 4096) { const int pos = e >> 6, i = e & 63; const float inv = powf(10000.0f, -(float)i / 64.0f); const float ang = (float)pos * inv; tr[2 * e] = cosf(ang); tr[2 * e + 1] = sinf(ang); }
          else { const int e2 = e - 4096, pos = e2 >> 4, i = e2 & 15; const float inv = powf(10000.0f, -(float)i / 16.0f); const float ang = (float)pos * inv; ta[2 * e2] = cosf(ang); ta[2 * e2 + 1] = sinf(ang); } } }
    { bf16_t* ck = (bf16_t*)(F.ws + WS_CK); bf16_t* cv = (bf16_t*)(F.ws + WS_CV);
      for (int e = (gw * 64 + lane) * 4; e < 524288; e += NGW * 64 * 4) {
          const f32x4 a = *(const f32x4*)(inp(F, 4) + e), b = *(const f32x4*)(inp(F, 5) + e);
          u32x2 wa = {cvtpk(a[0], a[1]), cvtpk(a[2], a[3])}, wb = {cvtpk(b[0], b[1]), cvtpk(b[2], b[3])};
          *(u32x2*)(ck + e) = wa; *(u32x2*)(cv + e) = wb; } }
    { bf16_t* w1t = (bf16_t*)(F.ob + OUT_W1T);
      const TrJob jobs[5] = { {inp(F, 12), 1024, 1024, w1t, 0, 1, 512}, {inp(F, 13), 1024, 1024, w1t, 1024, 1, 512}, {inp(F, 14), 1024, 2048, w1t, 2048, 0, 1024},
                              {inp(F, 15), 1024, 2048, w1t, 4096, 0, 1024}, {inp(F, 16), 1024, 2048, w1t, 6144, 0, 1024} };
      run_transposes<5>(jobs, scr, gw, NGW, lane); }
}

__device__ __forceinline__ void modulate_rows(Frame& F, const float* xa, const float* xb, const float* g, const float* modl, int shc, int scc, bf16_t* H) {
    PHASE_IDS();
    const int gw = F.vcu * NWAVES + wid, NGW = F.G * NWAVES;
    for (int row = gw; row < MROWS; row += NGW) {
        const float* src = row < NCTX ? xa + (size_t)row * 1024 : xb + (size_t)(row - NCTX) * 1024; const int mb = row < NCTX ? 8 : ((row - NCTX) >> 11);
        f32x4 v[4]; float ss = 0.f;
#pragma unroll
        for (int j = 0; j < 4; ++j) { v[j] = *(const f32x4*)(src + 4 * (lane + 64 * j)); ss += (v[j][0] * v[j][0] + v[j][1] * v[j][1]) + (v[j][2] * v[j][2] + v[j][3] * v[j][3]); }
        const float rstd = 1.0f / sqrtf(wave_sum(ss) * (1.0f / 1024.0f) + EPSV);
        const float* sh = modl + mb * 6144 + shc * 1024; const float* sc = modl + mb * 6144 + scc * 1024;
#pragma unroll
        for (int j = 0; j < 4; ++j) { const int col = 4 * (lane + 64 * j); const f32x4 gg = *(const f32x4*)(g + col), s1 = *(const f32x4*)(sc + col), s0 = *(const f32x4*)(sh + col);
            const f32x4 y = (v[j] * rstd) * gg * (1.0f + s1) + s0; u32x2 w = {cvtpk(y[0], y[1]), cvtpk(y[2], y[3])}; *(u32x2*)(H + (size_t)row * 1024 + col) = w; }
    }
}
__device__ __forceinline__ void final_norm(Frame& F, float* X, const float* g) {
    PHASE_IDS();
    const int gw = F.vcu * NWAVES + wid, NGW = F.G * NWAVES;
    for (int row = gw; row < MROWS; row += NGW) {
        float* src = X + (size_t)row * 1024; f32x4 v[4]; float ss = 0.f;
#pragma unroll
        for (int j = 0; j < 4; ++j) { v[j] = *(const f32x4*)(src + 4 * (lane + 64 * j)); ss += (v[j][0] * v[j][0] + v[j][1] * v[j][1]) + (v[j][2] * v[j][2] + v[j][3] * v[j][3]); }
        const float rstd = 1.0f / sqrtf(wave_sum(ss) * (1.0f / 1024.0f) + EPSV);
#pragma unroll
        for (int j = 0; j < 4; ++j) { const int col = 4 * (lane + 64 * j); const f32x4 gg = *(const f32x4*)(g + col); *(f32x4*)(src + col) = (v[j] * rstd) * gg; }
    }
}

__device__ __forceinline__ s16x4 vtr(const LAS unsigned char* p) { return __builtin_bit_cast(s16x4, __builtin_amdgcn_ds_read_tr16_b64_v4i16((LAS v4i16_t*)p)); }
__device__ __forceinline__ bf16x8 cat8(s16x4 lo, s16x4 hi) { return __builtin_shufflevector(lo, hi, 0, 1, 2, 3, 4, 5, 6, 7); }
__device__ __forceinline__ bf16x8 pack8(const f32x16& x, int s) {
    u32x4 p; p.x = cvtpk(x[8 * s], x[8 * s + 1]); p.y = cvtpk(x[8 * s + 2], x[8 * s + 3]); p.z = cvtpk(x[8 * s + 4], x[8 * s + 5]); p.w = cvtpk(x[8 * s + 6], x[8 * s + 7]);
    return __builtin_bit_cast(bf16x8, p);
}
constexpr int R_QT = 0, R_KT = 18432, R_VT = 36864, R_PT = 71680, R_VZ = 106496;
constexpr int R_QS = 144, R_VS = 272;
__device__ __forceinline__ void retention_item(Frame& F, int type, int b, int h, int dir, int sl) {
    PHASE_IDS();
    const int g = wid >> 2, w = wid & 3;
    LAS unsigned char* L = F.lds;
    const bf16_t* Qg = (const bf16_t*)(F.ws + WS_Q); const bf16_t* Kg = (const bf16_t*)(F.ws + WS_K); const bf16_t* Vg = (const bf16_t*)(F.ws + WS_V);
    bf16_t* SG = dir ? (bf16_t*)(F.ob + OUT_SGB) : (bf16_t*)(F.ws + WS_SGF);
    float* stats = (float*)(F.ws + CTL_STATS_B);
    const int nch = type ? 16 : 2, rowbase = type ? NCTX + b * 2048 : b * 256;
    const float raw = (dir ? inp(F, 19) : inp(F, 18))[h];
    const float lg2_ = -log1pf(expf(-raw)) * LOG2E;
    const int jt = wid >> 1, it0 = 2 * (wid & 1);
    f32x16 st[4];
    { const int n = lane & 31, h5 = lane >> 5;
      const float* S0 = (dir ? inp(F, 3) : inp(F, 2)) + (size_t)(b * 4 + h) * 256 * 512 + sl * 128 + 32 * w + n;
#pragma unroll
      for (int d = 0; d < 4; ++d)
#pragma unroll
          for (int r = 0; r < 16; ++r) st[d][r] = type ? S0[(size_t)(64 * d + 32 * g + crow(r, h5)) * 512] : 0.0f; }
    for (int cc = 0; cc < nch; ++cc) {
        const int c = dir ? nch - 1 - cc : cc; const int R0 = rowbase + 128 * c;
        int tl = tid; float lg2 = lg2_; asm volatile("" : "+v"(tl), "+v"(lg2));
        const int tid = tl, lane = tl & 63, n = lane & 31, h5 = lane >> 5, blk = (lane >> 4) & 1, q4 = (lane & 15) >> 2, p4 = lane & 3;
        const float g128 = exp2f(lg2 * 128.0f);
        f32x16 oacc[4], X0, X1;
#pragma unroll
        for (int i = 0; i < 16; ++i) { oacc[0][i] = 0.f; oacc[1][i] = 0.f; oacc[2][i] = 0.f; oacc[3][i] = 0.f; X0[i] = 0.f; X1[i] = 0.f; }
#pragma unroll
        for (int d = 0; d < 4; ++d) {
            __syncthreads();
            if (d == 0) {
                const int j = tid >> 2, pc = tid & 3; const bf16_t* src = Vg + (size_t)(R0 + j) * 2048 + h * 512 + sl * 128 + pc * 32;
                const float pj = (float)(dir ? 127 - j : j); const float zeta = exp2f(lg2 * (127.0f - pj));
#pragma unroll
                for (int ii = 0; ii < 4; ++ii) { const u32x4 vv = *(const u32x4*)(src + 8 * ii);
                    *(LAS u32x4*)(L + R_VT + j * R_VS + pc * 64 + 16 * ii) = vv;
                    u32x4 z; z.x = cvtpk(bflo(vv.x) * zeta, bfhi(vv.x) * zeta); z.y = cvtpk(bflo(vv.y) * zeta, bfhi(vv.y) * zeta); z.z = cvtpk(bflo(vv.z) * zeta, bfhi(vv.z) * zeta); z.w = cvtpk(bflo(vv.w) * zeta, bfhi(vv.w) * zeta);
                    *(LAS u32x4*)(L + R_VZ + j * R_VS + pc * 64 + 16 * ii) = z; }
            }
            { const int j = tid >> 2, pc = tid & 3; const size_t go = (size_t)(R0 + j) * 1024 + h * 256 + 64 * d + pc * 16;
              const u32x4 q0 = *(const u32x4*)(Qg + go), q1 = *(const u32x4*)(Qg + go + 8), k0 = *(const u32x4*)(Kg + go), k1 = *(const u32x4*)(Kg + go + 8);
              *(LAS u32x4*)(L + R_QT + j * R_QS + pc * 32) = q0; *(LAS u32x4*)(L + R_QT + j * R_QS + pc * 32 + 16) = q1;
              *(LAS u32x4*)(L + R_KT + j * R_QS + pc * 32) = k0; *(LAS u32x4*)(L + R_KT + j * R_QS + pc * 32 + 16) = k1; }
            __syncthreads();
#pragma unroll 1
            for (int s = 0; s < 4; ++s) {
                const bf16x8 a = *(const LAS bf16x8*)(L + R_KT + (32 * jt + n) * R_QS + (16 * s + 8 * h5) * 2);
                const bf16x8 b0 = *(const LAS bf16x8*)(L + R_QT + (32 * it0 + n) * R_QS + (16 * s + 8 * h5) * 2);
                const bf16x8 b1 = *(const LAS bf16x8*)(L + R_QT + (32 * (it0 + 1) + n) * R_QS + (16 * s + 8 * h5) * 2);
                X0 = MFMA32(a, b0, X0); X1 = MFMA32(a, b1, X1);
                PINV(X0); PINV(X1); FENCE();
            }
            FENCE();
#pragma unroll
            for (int s = 0; s < 2; ++s) {
                const bf16x8 bfr = pack8(st[d], s);
#pragma unroll
                for (int it = 0; it < 4; ++it) {
                    const LAS unsigned char* qp = L + R_QT + (32 * it + n) * R_QS + (32 * g + 16 * s + 4 * h5) * 2;
                    const s16x4 lo = *(const LAS s16x4*)qp, hi = *(const LAS s16x4*)(qp + 16);
                    oacc[it] = MFMA32(cat8(lo, hi), bfr, oacc[it]);
                    PINV(oacc[it]); FENCE();
                }
            }
#pragma unroll
            for (int r = 0; r < 16; ++r) st[d][r] *= g128;
            FENCE();
#pragma unroll 1
            for (int ks = 0; ks < 8; ++ks) {
                const int rowb = 16 * ks + 8 * h5 + q4;
                const LAS unsigned char* ka = L + R_KT + rowb * R_QS + (32 * g + 16 * blk) * 2 + 8 * p4;
                const LAS unsigned char* vb = L + R_VZ + rowb * R_VS + (32 * w + 16 * blk) * 2 + 8 * p4;
                const bf16x8 af = cat8(vtr(ka), vtr(ka + 4 * R_QS)), bfv = cat8(vtr(vb), vtr(vb + 4 * R_VS));
                st[d] = MFMA32(af, bfv, st[d]);
                PINV(st[d]); FENCE();
            }
        }
#pragma unroll
        for (int it = 0; it < 4; ++it)
#pragma unroll
            for (int r = 0; r < 16; ++r) { const int i = 32 * it + crow(r, h5); const float pi = (float)(dir ? 127 - i : i); oacc[it][r] *= exp2f(lg2 * (pi + 1.0f)); }
#pragma unroll
        for (int tt = 0; tt < 2; ++tt) {
            const int i = 32 * (it0 + tt) + n; const int pi = dir ? 127 - i : i;
#pragma unroll
            for (int r4 = 0; r4 < 4; ++r4) { const int j0 = 32 * jt + 8 * r4 + 4 * h5; float vv[4];
#pragma unroll
                for (int e = 0; e < 4; ++e) { const int j = j0 + e; const int pj = dir ? 127 - j : j; const int dd = pi - pj; const float x = tt ? X1[4 * r4 + e] : X0[4 * r4 + e];
                    vv[e] = dd >= 0 ? x * exp2f(lg2 * (float)dd) : 0.0f; }
                u32x2 wv = {cvtpk(vv[0], vv[1]), cvtpk(vv[2], vv[3])};
                *(LAS u32x2*)(L + R_PT + i * R_VS + j0 * 2) = wv; }
        }
        __syncthreads();
#pragma unroll 1
        for (int ks = 0; ks < 4; ++ks) {
            const int k0 = 64 * g + 16 * ks; const int rowb = k0 + 8 * h5 + q4;
            const LAS unsigned char* vb = L + R_VT + rowb * R_VS + (32 * w + 16 * blk) * 2 + 8 * p4;
            const bf16x8 bfv = cat8(vtr(vb), vtr(vb + 4 * R_VS));
#pragma unroll
            for (int it = 0; it < 4; ++it) { const bf16x8 af = *(const LAS bf16x8*)(L + R_PT + (32 * it + n) * R_VS + (k0 + 8 * h5) * 2); oacc[it] = MFMA32(af, bfv, oacc[it]); }
            PINV(oacc[0]); PINV(oacc[1]); PINV(oacc[2]); PINV(oacc[3]); FENCE();
        }
        __syncthreads();
        LAS float* XB = (LAS float*)(L + R_PT);
        if (g == 1) {
#pragma unroll
            for (int it = 0; it < 4; ++it)
#pragma unroll
                for (int r = 0; r < 16; ++r) XB[w * 4096 + (32 * it + crow(r, h5)) * 32 + n] = oacc[it][r];
        }
        __syncthreads();
        if (g == 0) {
#pragma unroll
            for (int it = 0; it < 4; ++it)
#pragma unroll
                for (int r = 0; r < 16; ++r) { LAS float* p = XB + w * 4096 + (32 * it + crow(r, h5)) * 32 + n; *p = *p + oacc[it][r]; }
        }
        __syncthreads();
        { const int i = tid >> 2, w2 = tid & 3; const LAS f32x4* p = (const LAS f32x4*)(XB + w2 * 4096 + i * 32);
          f32x4 o[8]; float ss = 0.f;
#pragma unroll
          for (int e = 0; e < 8; ++e) { o[e] = p[e]; ss += (o[e][0] * o[e][0] + o[e][1] * o[e][1]) + (o[e][2] * o[e][2] + o[e][3] * o[e][3]); }
          ss += __shfl_xor(ss, 1); ss += __shfl_xor(ss, 2);
          if (w2 == 0) atomicAdd(stats + ((size_t)(R0 + i) * 4 + h) * 2 + dir, ss);
          bf16_t* zp = SG + (size_t)(R0 + i) * 2048 + h * 512 + sl * 128 + 32 * w2;
#pragma unroll
          for (int e = 0; e < 4; ++e) { const u32x4 gv = *(const u32x4*)(zp + 8 * e); const f32x4 a = o[2 * e], c2 = o[2 * e + 1]; u32x4 z;
              z.x = cvtpk(a[0] * bflo(gv.x), a[1] * bfhi(gv.x)); z.y = cvtpk(a[2] * bflo(gv.y), a[3] * bfhi(gv.y));
              z.z = cvtpk(c2[0] * bflo(gv.z), c2[1] * bfhi(gv.z)); z.w = cvtpk(c2[2] * bflo(gv.w), c2[3] * bfhi(gv.w));
              *(u32x4*)(zp + 8 * e) = z; } }
    }
    if (type == 0) {
        const int n = lane & 31, h5 = lane >> 5;
        float* So = (float*)(F.ob + (dir ? OUT_SB : OUT_SF)) + (size_t)(b * 4 + h) * 256 * 512 + sl * 128 + 32 * w + n;
#pragma unroll
        for (int d = 0; d < 4; ++d)
#pragma unroll
            for (int r = 0; r < 16; ++r) So[(size_t)(64 * d + 32 * g + crow(r, h5)) * 512] = st[d][r];
    }
}
__device__ __forceinline__ void retention_phase(Frame& F) {
    for (int it = F.vcu; it < 1280; it += F.G) {
        if (it < 256) retention_item(F, 1, it >> 5, (it >> 3) & 3, (it >> 2) & 1, it & 3);
        else { const int i2 = it - 256; retention_item(F, 0, i2 >> 5, (i2 >> 3) & 3, (i2 >> 2) & 1, i2 & 3); }
    }
}
__device__ __forceinline__ void combine_rows(Frame& F) {
    PHASE_IDS();
    const int gw = F.vcu * NWAVES + wid, NGW = F.G * NWAVES;
    const bf16_t* zf = (const bf16_t*)(F.ws + WS_SGF); const bf16_t* zb = (const bf16_t*)(F.ob + OUT_SGB); bf16_t* Y = (bf16_t*)(F.ws + WS_Y);
    const float* stats = (const float*)(F.ws + CTL_STATS_B);
    for (int row = gw; row < MROWS; row += NGW) {
        const int h = lane >> 4; const float rf = 1.0f / sqrtf(stats[((size_t)row * 4 + h) * 2] * (1.0f / 512.0f) + EPSV), rb = 1.0f / sqrtf(stats[((size_t)row * 4 + h) * 2 + 1] * (1.0f / 512.0f) + EPSV);
        const size_t off = (size_t)row * 2048 + lane * 32;
#pragma unroll
        for (int e = 0; e < 4; ++e) { const u32x4 a = *(const u32x4*)(zf + off + 8 * e), c = *(const u32x4*)(zb + off + 8 * e); u32x4 y;
            y.x = cvtpk(rf * bflo(a.x) + rb * bflo(c.x), rf * bfhi(a.x) + rb * bfhi(c.x)); y.y = cvtpk(rf * bflo(a.y) + rb * bflo(c.y), rf * bfhi(a.y) + rb * bfhi(c.y));
            y.z = cvtpk(rf * bflo(a.z) + rb * bflo(c.z), rf * bfhi(a.z) + rb * bfhi(c.z)); y.w = cvtpk(rf * bflo(a.w) + rb * bflo(c.w), rf * bfhi(a.w) + rb * bfhi(c.w));
            *(u32x4*)(Y + off + 8 * e) = y; }
    }
}

constexpr int A_KT = 0, A_VT = 9216, A_WS = 18432, A_RS = 144;
__device__ __forceinline__ void attn_item(Frame& F, int type, int b, int kh, int qb) {
    PHASE_IDS();
    const int n = lane & 31, h5 = lane >> 5, blk = (lane >> 4) & 1, q4 = (lane & 15) >> 2, p4 = lane & 3;
    LAS unsigned char* L = F.lds; LAS float* wsf = (LAS float*)(L + A_WS) + wid * 32;
    const bf16_t* AQ = (const bf16_t*)(F.ws + WS_AQ); const bf16_t* AK = (const bf16_t*)(F.ws + WS_AK); const bf16_t* AV = (const bf16_t*)(F.ws + WS_AV);
    const bf16_t* CK = (const bf16_t*)(F.ws + WS_CK); const bf16_t* CV = (const bf16_t*)(F.ws + WS_CV); bf16_t* AO = (bf16_t*)(F.ws + WS_AO);
    const int gq = wid >> 1, rh = wid & 1, head = kh * 4 + gq;
    const int seq0 = type ? NCTX + b * 2048 : b * 256; const int qrow0 = seq0 + 64 * qb;
    bf16x8 qf[4];
#pragma unroll
    for (int s = 0; s < 4; ++s) qf[s] = *(const bf16x8*)(AQ + (size_t)(qrow0 + 32 * rh + n) * 1024 + head * 64 + 16 * s + 8 * h5);
    float mrun = -1e30f, lrun = 0.f; f32x16 o0, o1;
#pragma unroll
    for (int i = 0; i < 16; ++i) { o0[i] = 0.f; o1[i] = 0.f; }
    int blo = 0, bhi = -1;
    if (type) { blo = qb - 2 < 0 ? 0 : qb - 2; bhi = qb + 2 > 31 ? 31 : qb + 2; }
    const int ntile = 4 + (type ? bhi - blo + 1 : 0);
    for (int t = 0; t < ntile; ++t) {
        const bool band = t >= 4; const int kt = band ? blo + (t - 4) : t;
        const bf16_t *ks, *vs;
        if (type == 0) { ks = AK + (size_t)(seq0 + 64 * kt) * 256 + kh * 64; vs = AV + (size_t)(seq0 + 64 * kt) * 256 + kh * 64; }
        else if (!band) { ks = CK + (size_t)(b * 256 + 64 * kt) * 256 + kh * 64; vs = CV + (size_t)(b * 256 + 64 * kt) * 256 + kh * 64; }
        else { ks = AK + (size_t)(seq0 + 64 * kt) * 256 + kh * 64; vs = AV + (size_t)(seq0 + 64 * kt) * 256 + kh * 64; }
        __syncthreads();
        { const int j = tid >> 3, pc = tid & 7; const u32x4 kv = *(const u32x4*)(ks + (size_t)j * 256 + pc * 8), vv = *(const u32x4*)(vs + (size_t)j * 256 + pc * 8);
          *(LAS u32x4*)(L + A_KT + j * A_RS + pc * 16) = kv; *(LAS u32x4*)(L + A_VT + j * A_RS + pc * 16) = vv; }
        __syncthreads();
        f32x16 p0, p1;
#pragma unroll
        for (int i = 0; i < 16; ++i) { p0[i] = 0.f; p1[i] = 0.f; }
#pragma unroll
        for (int s = 0; s < 4; ++s) {
            const bf16x8 a0 = *(const LAS bf16x8*)(L + A_KT + n * A_RS + (16 * s + 8 * h5) * 2), a1 = *(const LAS bf16x8*)(L + A_KT + (32 + n) * A_RS + (16 * s + 8 * h5) * 2);
            p0 = MFMA32(a0, qf[s], p0); p1 = MFMA32(a1, qf[s], p1);
        }
        if (band) { const int qp = 64 * qb + 32 * rh + n;
#pragma unroll
            for (int r = 0; r < 16; ++r) { const int kp = 64 * kt + crow(r, h5); int d0 = qp - kp; d0 = d0 < 0 ? -d0 : d0; int d1 = qp - kp - 32; d1 = d1 < 0 ? -d1 : d1;
                if (d0 > 128) p0[r] = -1e30f; if (d1 > 128) p1[r] = -1e30f; } }
        float mx = p0[0];
#pragma unroll
        for (int r = 0; r < 16; ++r) { mx = fmaxf(mx, p0[r]); mx = fmaxf(mx, p1[r]); }
        mx = fmaxf(mx, __shfl_xor(mx, 32));
        const float mnew = fmaxf(mrun, mx); const float f = exp2f(mrun - mnew); mrun = mnew;
        float ls = 0.f;
#pragma unroll
        for (int r = 0; r < 16; ++r) { p0[r] = exp2f(p0[r] - mnew); p1[r] = exp2f(p1[r] - mnew); ls += p0[r] + p1[r]; }
        ls += __shfl_xor(ls, 32);
        lrun = lrun * f + ls;
        if (h5 == 0) wsf[n] = f;
        asm volatile("s_waitcnt lgkmcnt(0)" ::: "memory");
#pragma unroll
        for (int r = 0; r < 16; ++r) { const float fr_ = wsf[crow(r, h5)]; o0[r] *= fr_; o1[r] *= fr_; }
        asm volatile("s_waitcnt lgkmcnt(0)" ::: "memory");
#pragma unroll
        for (int tk = 0; tk < 2; ++tk)
#pragma unroll
            for (int s = 0; s < 2; ++s) {
                const bf16x8 af = tk ? pack8(p1, s) : pack8(p0, s);
                const int rowb = 32 * tk + 16 * s + 4 * h5 + q4;
                const LAS unsigned char* vb = L + A_VT + rowb * A_RS + (16 * blk) * 2 + 8 * p4;
                o0 = MFMA32(af, cat8(vtr(vb), vtr(vb + 8 * A_RS)), o0);
                o1 = MFMA32(af, cat8(vtr(vb + 64), vtr(vb + 64 + 8 * A_RS)), o1);
            }
    }
    lrun += exp2f(inp(F, 24)[head] * LOG2E - mrun);
    const float inv = 1.0f / lrun;
    if (h5 == 0) wsf[n] = inv;
    asm volatile("s_waitcnt lgkmcnt(0)" ::: "memory");
#pragma unroll
    for (int r = 0; r < 16; ++r) { const float iv = wsf[crow(r, h5)]; bf16_t* op = AO + (size_t)(qrow0 + 32 * rh + crow(r, h5)) * 1024 + head * 64 + n;
        op[0] = (bf16_t)(cvtpk(o0[r] * iv, 0.f) & 0xffffu); op[32] = (bf16_t)(cvtpk(o1[r] * iv, 0.f) & 0xffffu); }
    asm volatile("s_waitcnt lgkmcnt(0)" ::: "memory");
}
__device__ __forceinline__ void attn_phase(Frame& F) {
    for (int it = F.vcu; it < 1536; it += F.G) {
        if (it < 1024) attn_item(F, 1, it >> 7, (it >> 5) & 3, it & 31);
        else { const int i2 = it - 1024; attn_item(F, 0, i2 >> 4, (i2 >> 2) & 3, i2 & 3); }
    }
}

__global__ void __launch_bounds__(NWAVES * 64, 2) mega_fwd(Args args) {
    extern __shared__ __attribute__((aligned(16))) unsigned char lds_raw[];
    Frame F;
    F.lds = (LAS unsigned char*)lds_raw;
    volatile LAS unsigned* MISC = (volatile LAS unsigned*)(F.lds + MISC_OFF);
    F.G = gridDim.x; { const int bx = blockIdx.x; F.vcu = (F.G % 8 == 0) ? (bx % 8) * (F.G / 8) + bx / 8 : bx; }
    F.out = args.out; F.ws = args.ws; F.ob = (unsigned char*)args.out;
    for (int u = threadIdx.x; u < (LDS_BYTES - LDSCTL_OFF) / 4; u += NWAVES * 64) ((LAS unsigned*)(F.lds + LDSCTL_OFF))[u] = 0u;
    __syncthreads();
    if (threadIdx.x == 0) {
#pragma unroll
        for (int i = 0; i < 30; ++i) ((LAS unsigned long long*)(F.lds + INTAB_OFF))[i] = (unsigned long long)args.in[i];
    }
    __syncthreads();
    XcdBarrier bar = xcd_barrier_post((unsigned*)(F.ws + CTL_BAR_B), MISC + 8);
#define GRID_BAR() do { xcd_barrier(bar); asm volatile("" : "+s"(F.ws), "+s"(F.ob), "+s"(F.vcu), "+s"(F.G), "+s"(bx)); } while (0)
#define mod ((float*)(F.ws + CTL_MOD_B))
#define X ((float*)F.ob)
#define H ((bf16_t*)(F.ws + WS_H))
    int bx = (int)blockIdx.x;

#ifndef NO_P0
    p0_prologue(F);
#endif
    GRID_BAR();
    modulate_rows(F, inp(F, 0), inp(F, 1), inp(F, 10), mod, 0, 1, (bf16_t*)(F.ob + OUT_H0)); GRID_BAR();
    { pg8::Gemm g{(const bf16_t*)(F.ob + OUT_H0), (const bf16_t*)(F.ob + OUT_W1T), 1024}; pg8::TileOrder S; S.init(96, 32, F.G, bx, 0);
      pg8::EpiRet E{(bf16_t*)(F.ws + WS_Q), (bf16_t*)(F.ws + WS_K), (bf16_t*)(F.ws + WS_V), (bf16_t*)(F.ws + WS_SGF), (bf16_t*)(F.ob + OUT_SGB), (const float*)(F.ws + WS_TABR)};
      pg8::gemm_phase(F.lds, g, S, E); }
    GRID_BAR();
#ifndef NO_RET
    retention_phase(F);
#endif
    GRID_BAR();
    { combine_rows(F);
      PHASE_IDS();
      LAS float* scr = (LAS float*)(F.lds + wid * 16384); const int gw = F.vcu * NWAVES + wid, NGW = F.G * NWAVES;
      bf16_t* wqkv = (bf16_t*)(F.ws + WS_WQKV);
      const TrJob jobs[10] = { {inp(F, 17), 2048, 1024, (bf16_t*)(F.ws + WS_WO_RET), 0, 0, 1024},
                               {inp(F, 25), 1024, 5632, (bf16_t*)(F.ws + WS_WIN0), 0, 3, 2816}, {inp(F, 25) + (size_t)1024 * 5632, 1024, 5632, (bf16_t*)(F.ws + WS_WIN1), 0, 3, 2816},
                               {inp(F, 28), 2816, 1024, (bf16_t*)(F.ws + WS_WOUT0), 0, 0, 1408}, {inp(F, 28) + (size_t)2816 * 1024, 2816, 1024, (bf16_t*)(F.ws + WS_WOUT1), 0, 0, 1408},
                               {inp(F, 20), 1024, 1024, wqkv, 0, 2, 512}, {inp(F, 21), 1024, 256, wqkv, 1024, 2, 128}, {inp(F, 22), 1024, 256, wqkv, 1280, 0, 128},
                               {inp(F, 23), 1024, 1024, (bf16_t*)(F.ws + WS_WOA), 0, 0, 512}, {nullptr, 0, 32, nullptr, 0, 0, 0} };
#ifndef NO_P4T
      run_transposes<10>(jobs, scr, gw, NGW, lane);
#endif
    }
    GRID_BAR();
    { pg8::Gemm g{(const bf16_t*)(F.ws + WS_Y), (const bf16_t*)(F.ws + WS_WO_RET), 2048}; pg8::TileOrder S; S.init(96, 4, F.G, bx, 0);
      pg8::EpiResid E{inp(F, 0), inp(F, 1), X, mod + 2 * 1024};
      pg8::gemm_phase(F.lds, g, S, E); }
    GRID_BAR();
#pragma unroll 1
    for (int l = 0; l < 2; ++l) {
        const float* modl = mod + l * 9 * 6144;
        if (l == 1) {
            modulate_rows(F, X, X + (size_t)NCTX * 1024, inp(F, 10) + 1024, modl, 0, 1, H); GRID_BAR();
            { pg8::Gemm g{H, (const bf16_t*)(F.ws + WS_WQKV), 1024}; pg8::TileOrder S; S.init(96, 6, F.G, bx, 0);
              pg8::EpiAttnQKV E{(bf16_t*)(F.ws + WS_AQ), (bf16_t*)(F.ws + WS_AK), (bf16_t*)(F.ws + WS_AV), (float*)(F.ob + OUT_NK), (float*)(F.ob + OUT_NV), (const float*)(F.ws + WS_TABA)};
              pg8::gemm_phase(F.lds, g, S, E); }
            GRID_BAR();
#ifndef NO_ATTN
            attn_phase(F);
#endif
            GRID_BAR();
            { pg8::Gemm g{(const bf16_t*)(F.ws + WS_AO), (const bf16_t*)(F.ws + WS_WOA), 1024}; pg8::TileOrder S; S.init(96, 4, F.G, bx, 0);
              pg8::EpiResid E{X, X + (size_t)NCTX * 1024, X, modl + 2 * 1024};
              pg8::gemm_phase(F.lds, g, S, E); }
            GRID_BAR();
        }
        modulate_rows(F, X, X + (size_t)NCTX * 1024, inp(F, 11) + l * 1024, modl, 3, 4, H); GRID_BAR();
        { pg8::Gemm g{H, (const bf16_t*)(F.ws + (l ? WS_WIN1 : WS_WIN0)), 1024}; pg8::TileOrder S; S.init(104, 22, F.G, bx, 1);
          pg8::EpiFfn E{(bf16_t*)(F.ws + WS_ACT), inp(F, 26) + (size_t)l * 3 * 5632, inp(F, 27) + (size_t)l * 5632, (LAS float*)(F.lds + XCH_OFF)};
#ifndef NO_FFN
          pg8::gemm_phase(F.lds, g, S, E);
#endif
        }
        GRID_BAR();
        { pg8::Gemm g{(const bf16_t*)(F.ws + WS_ACT), (const bf16_t*)(F.ws + (l ? WS_WOUT1 : WS_WOUT0)), 2816}; pg8::TileOrder S; S.init(96, 4, F.G, bx, 0);
          pg8::EpiResid E{X, X + (size_t)NCTX * 1024, X, modl + 5 * 1024};
          pg8::gemm_phase(F.lds, g, S, E); }
        GRID_BAR();
    }
    final_norm(F, X, inp(F, 29));
#undef mod
#undef X
#undef H
}

extern "C" void kernel_launch(void* const* d_in, const int* in_sizes, int n_in, void* d_out, int out_size, void* d_ws, size_t ws_size, hipStream_t stream) {
    static int grid = 0;
    if (grid == 0) {
        if (n_in != 30 || out_size != 62914560 || ws_size < WS_NEED) { fprintf(stderr, "kernel_launch: unexpected problem: n_in %d out %d ws %zu (need %zu)\n", n_in, out_size, ws_size, (size_t)WS_NEED); grid = -1; return; }
        int dev = 0, cus = 0, per_cu = 0;
        if (hipGetDevice(&dev) != hipSuccess || hipDeviceGetAttribute(&cus, hipDeviceAttributeMultiprocessorCount, dev) != hipSuccess) { grid = -1; return; }
        if (hipFuncSetAttribute((const void*)mega_fwd, hipFuncAttributeMaxDynamicSharedMemorySize, LDS_BYTES) != hipSuccess) { fprintf(stderr, "kernel_launch: hipFuncSetAttribute failed\n"); grid = -1; return; }
        if (hipOccupancyMaxActiveBlocksPerMultiprocessor(&per_cu, (const void*)mega_fwd, NWAVES * 64, LDS_BYTES) != hipSuccess || per_cu < 1) { fprintf(stderr, "kernel_launch: occupancy query says %d\n", per_cu); per_cu = 1; }
        (void)hipGetLastError();
        grid = cus;
    }
    if (grid < 0) return;
    (void)hipMemsetAsync((char*)d_ws, 0, CTL_BYTES, stream);
    Args a{};
    for (int i = 0; i < 30; ++i) a.in[i] = (const float*)d_in[i];
    a.out = (float*)d_out; a.ws = (unsigned char*)d_ws;
    void* kargs[] = {&a};
    hipError_t e = hipLaunchCooperativeKernel((const void*)mega_fwd, dim3(grid), dim3(NWAVES * 64), kargs, LDS_BYTES, stream);
    if (e != hipSuccess) { (void)hipGetLastError(); fprintf(stderr, "kernel_launch: cooperative launch failed (%s); plain launch\n", hipGetErrorString(e));
        hipLaunchKernelGGL(mega_fwd, dim3(grid), dim3(NWAVES * 64), LDS_BYTES, stream, a); }
}
```

```cpp
#include <hip/hip_runtime.h>
#include <cstdio>
#include <cstdint>
#ifndef PROBE_DUP
#define PROBE_DUP 0
#endif

#define LAS __attribute__((address_space(3)))
#define GAS __attribute__((address_space(1)))
typedef unsigned short bf16_t;
typedef short bf16x8 __attribute__((ext_vector_type(8)));
typedef short s16x4 __attribute__((ext_vector_type(4)));
typedef short v4i16_t __attribute__((ext_vector_type(4)));
typedef float f32x2 __attribute__((ext_vector_type(2)));
typedef float f32x4 __attribute__((ext_vector_type(4)));
typedef float f32x16 __attribute__((ext_vector_type(16)));
typedef unsigned u32x2 __attribute__((ext_vector_type(2)));
typedef unsigned u32x4 __attribute__((ext_vector_type(4)));
typedef __bf16 bf16x2_t __attribute__((ext_vector_type(2)));

constexpr int DM = 1024, NCTX = 8192, NLAT = 16384, MROWS = 24576, DFF = 2816;
constexpr float EPSV = 1e-6f;
constexpr float LOG2E = 1.4426950408889634f;

__device__ __forceinline__ unsigned cvtpk(float lo, float hi) { f32x2 v = {lo, hi}; bf16x2_t b = __builtin_convertvector(v, bf16x2_t); return __builtin_bit_cast(unsigned, b); }
__device__ __forceinline__ float bf2f(unsigned short x) { return __uint_as_float((unsigned)x << 16); }
__device__ __forceinline__ float bflo(unsigned w) { return __uint_as_float(w << 16); }
__device__ __forceinline__ float bfhi(unsigned w) { return __uint_as_float(w & 0xffff0000u); }
__device__ __forceinline__ float silu_f(float x) { return x * __builtin_amdgcn_rcpf(1.0f + __expf(-x)); }
__device__ __forceinline__ int crow(int r, int h) { return (r & 3) + 8 * (r >> 2) + 4 * h; }
#define PIN4(a, b, c, d) asm volatile("" : "+v"(a), "+v"(b), "+v"(c), "+v"(d))
#define PINV(x) asm volatile("" : "+v"(x))
#define FENCE() do { asm volatile("" ::: "memory"); __builtin_amdgcn_sched_barrier(0); } while (0)
#define MFMA32(a, b, c) __builtin_amdgcn_mfma_f32_32x32x16_bf16((a), (b), (c), 0, 0, 0)

namespace pg8 {
constexpr int BM = 256, BK = 64, HALF = 128, HTB = HALF * BK * 2, STAGE_BYTES = 8 * HTB, NXCD = 8, WGM = 8;
__host__ __device__ __forceinline__ int lds_byte(int r, int c) { const int st = (r >> 4) * 2 + (c >> 5), rr = r & 15, cc = c & 31, ob = rr * 64 + cc * 2; return st * 1024 + (ob ^ (((ob >> 9) & 1) << 5)); }
__host__ __device__ __forceinline__ void stage_rc(int b, int& R, int& C) { const int st = b / 1024, sb = b % 1024, swz = sb ^ (((sb >> 9) & 1) << 5); R = (st >> 1) * 16 + swz / 64; C = (st & 1) * 32 + (swz % 64) / 2; }
__host__ __device__ __forceinline__ int perm32(int rho) { const int n = rho >> 4, i = rho & 15; return 8 * (i >> 2) + 4 * n + (i & 3); }

struct Unit { int pm, pn, row0; };
struct Gemm { const bf16_t* A; const bf16_t* Bt; int K; };

__device__ __forceinline__ int ffn_row0(int pm) {
    if (pm < 32) return pm * 256;
    const int p = pm - 32, b = p / 9, k = p - 9 * b; const int s = 254 * k; return NCTX + b * 2048 + (s > 1792 ? 1792 : s);
}
struct TileOrder {
    int nM, nN, nwg, G, c, ffn;
    __device__ __forceinline__ void init(int nM_, int nN_, int G_, int c_, int ffn_) { nM = nM_; nN = nN_; nwg = nM * nN; G = G_; c = c_; ffn = ffn_; }
    __device__ __forceinline__ bool next(int i, Unit& u) const {
        const long L = (long)i * G + c; if (L >= nwg) return false;
        int wgid = (int)L; { const int q = nwg / NXCD, r = nwg % NXCD, xcd = wgid % NXCD, off = wgid / NXCD; wgid = (xcd < r ? xcd * (q + 1) : r * (q + 1) + (xcd - r) * q) + off; }
        const int nig = WGM * nN, gid = wgid / nig, fm = gid * WGM, gsz = (nM - fm) < WGM ? (nM - fm) : WGM;
        u.pm = fm + ((wgid % nig) % gsz); u.pn = (wgid % nig) / gsz;
        u.row0 = ffn ? ffn_row0(u.pm) : u.pm * BM; return true;
    }
};


struct EpiRet {
    static constexpr bool PERM = true;
    bf16_t *q, *k, *v, *sgf, *sgb; const float* tab;
    __device__ __forceinline__ void operator()(const f32x4 (&acc)[2][2][4][2], const Unit& u, int wr, int wc, int fr, int fq) const {
        const int pn = u.pn; const int rbase = u.row0 + wr * 64 + fr;
        if (pn < 8) {
            const bool isk = pn >= 4; bf16_t* dst = (isk ? k : q) + (pn & 3) * 256; const float sc = isk ? 0.0625f : 1.0f;
            const bool lat = u.row0 >= NCTX; const int i0 = 4 * (4 * wc + fq);
#pragma unroll
            for (int ai = 0; ai < 2; ++ai)
#pragma unroll
                for (int m = 0; m < 4; ++m) { const int r = rbase + ai * HALF + m * 16; const int s = (r - NCTX) & 2047;
                    f32x4 av[2][2] = {{acc[ai][0][m][0], acc[ai][0][m][1]}, {acc[ai][1][m][0], acc[ai][1][m][1]}}; PIN4(av[0][0], av[0][1], av[1][0], av[1][1]);
#pragma unroll
                    for (int bj = 0; bj < 2; ++bj) { const int pos = bj ? (s & 63) : (s >> 6);
                        f32x4 x1 = av[bj][0] * sc, x2 = av[bj][1] * sc, o1 = x1, o2 = x2;
                        if (lat) { const f32x4* tp = (const f32x4*)(tab + (pos * 64 + i0) * 2); const f32x4 t0 = tp[0], t1 = tp[1];
                            const f32x4 cs = {t0[0], t0[2], t1[0], t1[2]}, sn = {t0[1], t0[3], t1[1], t1[3]};
                            o1 = x1 * cs - x2 * sn; o2 = x1 * sn + x2 * cs; }
                        bf16_t* p = dst + (size_t)r * 1024 + 128 * bj + i0;
                        u32x2 w1 = {cvtpk(o1[0], o1[1]), cvtpk(o1[2], o1[3])}, w2 = {cvtpk(o2[0], o2[1]), cvtpk(o2[2], o2[3])};
                        *(u32x2*)p = w1; *(u32x2*)(p + 64) = w2; }
                    asm volatile("" ::: "memory"); }
        } else if (pn < 16) { store_plain(acc, v, (pn - 8) * 256, false, rbase, wc, fq); }
        else if (pn < 24) { store_plain(acc, sgf, (pn - 16) * 256, true, rbase, wc, fq); }
        else { store_plain(acc, sgb, (pn - 24) * 256, true, rbase, wc, fq); }
    }
    __device__ __forceinline__ void store_plain(const f32x4 (&acc)[2][2][4][2], bf16_t* dst, int col0, bool act, int rbase, int wc, int fq) const {
        const int col = col0 + wc * 32 + 8 * fq;
#pragma unroll
        for (int ai = 0; ai < 2; ++ai)
#pragma unroll
            for (int m = 0; m < 4; ++m) { bf16_t* rowp = dst + (size_t)(rbase + ai * HALF + m * 16) * 2048 + col;
                f32x4 av[2][2] = {{acc[ai][0][m][0], acc[ai][0][m][1]}, {acc[ai][1][m][0], acc[ai][1][m][1]}}; PIN4(av[0][0], av[0][1], av[1][0], av[1][1]);
#pragma unroll
                for (int bj = 0; bj < 2; ++bj) { f32x4 v0 = av[bj][0], v1 = av[bj][1];
                    if (act) { for (int j = 0; j < 4; ++j) { v0[j] = silu_f(v0[j]); v1[j] = silu_f(v1[j]); } }
                    u32x4 w; w.x = cvtpk(v0[0], v0[1]); w.y = cvtpk(v0[2], v0[3]); w.z = cvtpk(v1[0], v1[1]); w.w = cvtpk(v1[2], v1[3]);
                    *(u32x4*)(rowp + bj * HALF) = w; }
                asm volatile("" ::: "memory"); }
    }
};

struct EpiResid {
    static constexpr bool PERM = false;
    const float* xa; const float* xb; float* xo; const float* gate;
    __device__ __forceinline__ void operator()(const f32x4 (&acc)[2][2][4][2], const Unit& u, int wr, int wc, int fr, int fq) const {
        const int col0 = u.pn * BM + wc * 32 + 4 * fq; const int mb = u.row0 < NCTX ? 8 : ((u.row0 - NCTX) >> 11);
        const float* xin = u.row0 < NCTX ? xa + (size_t)u.row0 * 1024 : xb + (size_t)(u.row0 - NCTX) * 1024;
        float* xout = xo + (size_t)u.row0 * 1024; const float* gp = gate + mb * 6144 + col0;
        f32x4 gv[2][2];
#pragma unroll
        for (int bj = 0; bj < 2; ++bj)
#pragma unroll
            for (int n = 0; n < 2; ++n) gv[bj][n] = *(const f32x4*)(gp + bj * HALF + n * 16);
#pragma unroll
        for (int ai = 0; ai < 2; ++ai)
#pragma unroll
            for (int m = 0; m < 4; ++m) { const size_t off = (size_t)(ai * HALF + wr * 64 + m * 16 + fr) * 1024 + col0;
                f32x4 av[2][2] = {{acc[ai][0][m][0], acc[ai][0][m][1]}, {acc[ai][1][m][0], acc[ai][1][m][1]}}; PIN4(av[0][0], av[0][1], av[1][0], av[1][1]);
#pragma unroll
                for (int bj = 0; bj < 2; ++bj)
#pragma unroll
                    for (int n = 0; n < 2; ++n) { const f32x4 bs = *(const f32x4*)(xin + off + bj * HALF + n * 16);
                        *(f32x4*)(xout + off + bj * HALF + n * 16) = bs + gv[bj][n] * av[bj][n]; }
                asm volatile("" ::: "memory"); }
    }
};

struct EpiAttnQKV {
    static constexpr bool PERM = true;
    bf16_t *q, *k, *v; float *ok, *ov; const float* tab;
    __device__ __forceinline__ void operator()(const f32x4 (&acc)[2][2][4][2], const Unit& u, int wr, int wc, int fr, int fq) const {
        const int pn = u.pn; const int rbase = u.row0 + wr * 64 + fr; const bool lat = u.row0 >= NCTX;
        if (pn < 5) {
            const bool isk = pn == 4; const float sc = isk ? 1.0f : 0.125f * LOG2E; const int half = wc & 1, i0 = 4 * fq;
#pragma unroll
            for (int ai = 0; ai < 2; ++ai)
#pragma unroll
                for (int m = 0; m < 4; ++m) { const int r = rbase + ai * HALF + m * 16; const int s = (r - NCTX) & 2047; const int pos = half ? (s & 63) : (s >> 6);
                    f32x4 av[2][2] = {{acc[ai][0][m][0], acc[ai][0][m][1]}, {acc[ai][1][m][0], acc[ai][1][m][1]}}; PIN4(av[0][0], av[0][1], av[1][0], av[1][1]);
                    f32x4 cs = {1.f, 1.f, 1.f, 1.f}, sn = {0.f, 0.f, 0.f, 0.f};
                    if (lat) { const f32x4* tp = (const f32x4*)(tab + (pos * 16 + i0) * 2); const f32x4 t0 = tp[0], t1 = tp[1];
                        cs = (f32x4){t0[0], t0[2], t1[0], t1[2]}; sn = (f32x4){t0[1], t0[3], t1[1], t1[3]}; }
#pragma unroll
                    for (int bj = 0; bj < 2; ++bj) { const int hh = 2 * bj + (wc >> 1);
                        const f32x4 x1 = av[bj][0], x2 = av[bj][1];
                        const f32x4 o1 = (x1 * cs - x2 * sn) * sc, o2 = (x1 * sn + x2 * cs) * sc;
                        const int t1c = 32 * half + i0;
                        bf16_t* p = isk ? k + (size_t)r * 256 + hh * 64 + t1c : q + (size_t)r * 1024 + (pn * 4 + hh) * 64 + t1c;
                        u32x2 w1 = {cvtpk(o1[0], o1[1]), cvtpk(o1[2], o1[3])}, w2 = {cvtpk(o2[0], o2[1]), cvtpk(o2[2], o2[3])};
                        *(u32x2*)p = w1; *(u32x2*)(p + 16) = w2;
                        if (isk && !lat) { float* o = ok + (size_t)r * 256 + hh * 64 + t1c; *(f32x4*)o = x1; *(f32x4*)(o + 16) = x2; } }
                    asm volatile("" ::: "memory"); }
        } else {
            const int col = wc * 32 + 8 * fq;
#pragma unroll
            for (int ai = 0; ai < 2; ++ai)
#pragma unroll
                for (int m = 0; m < 4; ++m) { const int r = rbase + ai * HALF + m * 16;
                    f32x4 av[2][2] = {{acc[ai][0][m][0], acc[ai][0][m][1]}, {acc[ai][1][m][0], acc[ai][1][m][1]}}; PIN4(av[0][0], av[0][1], av[1][0], av[1][1]);
#pragma unroll
                    for (int bj = 0; bj < 2; ++bj) { const f32x4 v0 = av[bj][0], v1 = av[bj][1];
                        u32x4 w; w.x = cvtpk(v0[0], v0[1]); w.y = cvtpk(v0[2], v0[3]); w.z = cvtpk(v1[0], v1[1]); w.w = cvtpk(v1[2], v1[3]);
                        *(u32x4*)(v + (size_t)r * 256 + col + bj * HALF) = w;
                        if (!lat) { float* o = ov + (size_t)r * 256 + col + bj * HALF; *(f32x4*)o = v0; *(f32x4*)(o + 4) = v1; } }
                    asm volatile("" ::: "memory"); }
        }
    }
};

struct EpiFfn {
    static constexpr bool PERM = true;
    bf16_t* act; const float* cw; const float* cb; LAS float* xch;
    __device__ __forceinline__ void operator()(const f32x4 (&acc)[2][2][4][2], const Unit& u, int wr, int wc, int fr, int fq) const {
        const int lane = 16 * fq + fr;
        int lo = 0, hi = 256;
        if (u.pm >= 32) { const int k = (u.pm - 32) % 9; if (k == 0) { hi = 255; } else if (k < 8) { lo = 1; hi = 255; } else { lo = 241; hi = 256; } }
#pragma unroll
        for (int ai = 0; ai < 2; ++ai)
#pragma unroll
            for (int bj = 0; bj < 2; ++bj) {
                if (fr == 0) { LAS f32x4* p = (LAS f32x4*)xch + ((((ai * 2 + wr) * 2 + 0) * 4 + wc) * 4 + fq) * 4 + bj * 2; p[0] = acc[ai][bj][0][0]; p[1] = acc[ai][bj][0][1]; }
                if (fr == 15) { LAS f32x4* p = (LAS f32x4*)xch + ((((ai * 2 + wr) * 2 + 1) * 4 + wc) * 4 + fq) * 4 + bj * 2; p[0] = acc[ai][bj][3][0]; p[1] = acc[ai][bj][3][1]; }
            }
        asm volatile("s_waitcnt lgkmcnt(0)" ::: "memory"); __builtin_amdgcn_s_barrier(); asm volatile("" ::: "memory");
        const int lprev = (lane & 48) | ((fr + 15) & 15), lnext = (lane & 48) | ((fr + 1) & 15);
#pragma unroll
        for (int bj = 0; bj < 2; ++bj) {
            const int c0 = u.pn * 128 + 64 * bj + 16 * wc + 4 * fq;
            const f32x4 wu0 = *(const f32x4*)(cw + c0), wu1 = *(const f32x4*)(cw + 5632 + c0), wu2 = *(const f32x4*)(cw + 2 * 5632 + c0), bu = *(const f32x4*)(cb + c0);
            const f32x4 wg0 = *(const f32x4*)(cw + DFF + c0), wg1 = *(const f32x4*)(cw + 5632 + DFF + c0), wg2 = *(const f32x4*)(cw + 2 * 5632 + DFF + c0), bg = *(const f32x4*)(cb + DFF + c0);
#pragma unroll
            for (int ai = 0; ai < 2; ++ai) {
                f32x4 pu = {0.f, 0.f, 0.f, 0.f}, pg = pu, nu = pu, ng = pu;
                { int pai = ai, pwr = wr - 1; if (pwr < 0) { pwr = 1; pai = ai - 1; }
                  if (pai >= 0) { const LAS f32x4* p = (const LAS f32x4*)xch + ((((pai * 2 + pwr) * 2 + 1) * 4 + wc) * 4 + fq) * 4 + bj * 2; pu = p[0]; pg = p[1]; }
                  int nai = ai, nwr = wr + 1; if (nwr > 1) { nwr = 0; nai = ai + 1; }
                  if (nai < 2) { const LAS f32x4* p = (const LAS f32x4*)xch + ((((nai * 2 + nwr) * 2 + 0) * 4 + wc) * 4 + fq) * 4 + bj * 2; nu = p[0]; ng = p[1]; } }
#pragma unroll
                for (int m = 0; m < 4; ++m) {
                    f32x4 uc = acc[ai][bj][m][0], gc = acc[ai][bj][m][1];
                    f32x4 sp_u = (m > 0 && fr == 15) ? acc[ai][bj][m > 0 ? m - 1 : 0][0] : uc, sp_g = (m > 0 && fr == 15) ? acc[ai][bj][m > 0 ? m - 1 : 0][1] : gc;
                    f32x4 sn_u = (m < 3 && fr == 0) ? acc[ai][bj][m < 3 ? m + 1 : 3][0] : uc, sn_g = (m < 3 && fr == 0) ? acc[ai][bj][m < 3 ? m + 1 : 3][1] : gc;
                    PIN4(uc, gc, sp_u, sp_g); PIN4(sn_u, sn_g, uc, gc);
                    f32x4 up, gp, un, gn;
#pragma unroll
                    for (int j = 0; j < 4; ++j) { up[j] = __shfl(sp_u[j], lprev); gp[j] = __shfl(sp_g[j], lprev); un[j] = __shfl(sn_u[j], lnext); gn[j] = __shfl(sn_g[j], lnext); }
                    if (m == 0 && fr == 0) { up = pu; gp = pg; }
                    if (m == 3 && fr == 15) { un = nu; gn = ng; }
                    const f32x4 uu = wu0 * up + wu1 * uc + wu2 * un + bu;
                    const f32x4 gg = wg0 * gp + wg1 * gc + wg2 * gn + bg;
                    const int lr = ai * HALF + wr * 64 + m * 16 + fr;
                    if (lr >= lo && lr < hi) { u32x2 w = {cvtpk(silu_f(gg[0]) * uu[0], silu_f(gg[1]) * uu[1]), cvtpk(silu_f(gg[2]) * uu[2], silu_f(gg[3]) * uu[3])};
                        *(u32x2*)(act + (size_t)(u.row0 + lr) * DFF + c0) = w; }
                    asm volatile("" ::: "memory");
                }
            }
        }
        asm volatile("s_waitcnt lgkmcnt(0)" ::: "memory"); __builtin_amdgcn_s_barrier(); asm volatile("" ::: "memory");
    }
};

template <class Epi, class Sched>
__device__ __forceinline__ void gemm_phase(LAS unsigned char* lds, const Gemm g, const Sched& S, const Epi& E) {
    int tid_ = threadIdx.x; asm volatile("" : "+v"(tid_));
    const int tid = tid_, wid = __builtin_amdgcn_readfirstlane(tid >> 6), lane = tid & 63, wr = wid >> 2, wc = wid & 3, fr = lane & 15, fq = lane >> 4;
    const int K = g.K, nt = K / BK;
    unsigned voffA[2], voffB[2];
#pragma unroll
    for (int i = 0; i < 2; ++i) { int R, C; stage_rc(tid * 16 + i * 8192, R, C); const int Rb = Epi::PERM ? ((R & ~31) + perm32(R & 31)) : R;
        voffA[i] = (unsigned)(R * K + C) * 2u; voffB[i] = (unsigned)(Rb * K + C) * 2u; }
    const size_t kstep = (size_t)(BK * 2);
    const size_t hstep = (size_t)HALF * K * 2;
    const size_t tstep = 2 * hstep;
    const size_t rstep = (size_t)K * 2;
    const unsigned ldsw = (unsigned)wid * 1024u;
    const int aoff = lds_byte(wr * 64 + fr, fq * 8), boff = lds_byte(wc * 32 + fr, fq * 8);
#define PG8_SA(b, h) (((b) * 2 + (h)) * HTB)
#define PG8_SB(b, h) ((4 + (b) * 2 + (h)) * HTB)
#define PG8_STAGE(bufoff, gbase, voff) do { _Pragma("unroll") for (int _i = 0; _i < 2; ++_i) \
        __builtin_amdgcn_global_load_lds((const unsigned*)((const char*)(gbase) + (voff)[_i]), (LAS unsigned*)(lds + (bufoff) + ldsw + _i * 8192), 16, 0, 0); } while (0)
#define PG8_LDA(dst, b, h) do { _Pragma("unroll") for (int m = 0; m < 4; ++m) _Pragma("unroll") for (int k = 0; k < 2; ++k) dst[m][k] = *(const LAS bf16x8*)(lds + PG8_SA(b, h) + aoff + m * 2048 + k * 1024); } while (0)
#define PG8_LDB(dst, b, h) do { _Pragma("unroll") for (int n = 0; n < 2; ++n) _Pragma("unroll") for (int k = 0; k < 2; ++k) dst[n][k] = *(const LAS bf16x8*)(lds + PG8_SB(b, h) + boff + n * 2048 + k * 1024); } while (0)
#define PG8_MMA(ai, bj, At, Bt) do { __builtin_amdgcn_s_setprio(1); _Pragma("unroll") for (int m = 0; m < 4; ++m) _Pragma("unroll") for (int n = 0; n < 2; ++n) _Pragma("unroll") for (int k = 0; k < 2; ++k) \
        acc[ai][bj][m][n] = __builtin_amdgcn_mfma_f32_16x16x32_bf16(Bt[n][k], At[m][k], acc[ai][bj][m][n], 0, 0, 0); __builtin_amdgcn_s_setprio(0); } while (0)
#define PG8_WAIT_V(n) asm volatile("s_waitcnt vmcnt(" #n ")" ::: "memory")
#define PG8_WAIT_L(n) asm volatile("s_waitcnt lgkmcnt(" #n ")" ::: "memory")
#define PG8_BAR __builtin_amdgcn_s_barrier()
#define PG8_SCHED __builtin_amdgcn_sched_barrier(0)
    Unit cur, nxt; int ui = 0;
    if (!S.next(0, cur)) return;
    f32x4 acc[2][2][4][2];
#pragma unroll
    for (int a = 0; a < 2; ++a)
#pragma unroll
        for (int b = 0; b < 2; ++b)
#pragma unroll
            for (int m = 0; m < 4; ++m)
#pragma unroll
                for (int n = 0; n < 2; ++n) acc[a][b][m][n] = (f32x4){0.f, 0.f, 0.f, 0.f};
    bf16x8 At[4][2], B0[2][2], B1[2][2];
    const char* cA = (const char*)g.A + (size_t)cur.row0 * rstep; const char* cB = (const char*)g.Bt + (size_t)cur.pn * tstep;
    PG8_STAGE(PG8_SB(0, 0), cB, voffB); PG8_STAGE(PG8_SB(0, 1), cB + hstep, voffB); PG8_STAGE(PG8_SA(0, 0), cA, voffA); PG8_STAGE(PG8_SA(0, 1), cA + hstep, voffA);
    if (wr == 1) PG8_BAR;
    PG8_WAIT_V(2); PG8_BAR;
    PG8_STAGE(PG8_SB(1, 0), cB + kstep, voffB); PG8_STAGE(PG8_SA(1, 0), cA + kstep, voffA); PG8_STAGE(PG8_SB(1, 1), cB + hstep + kstep, voffB);
    PG8_WAIT_V(6); PG8_BAR;
    for (;;) {
        const bool has_next = S.next(ui + 1, nxt);
        const char* nA = has_next ? (const char*)g.A + (size_t)nxt.row0 * rstep : cA; const char* nB = has_next ? (const char*)g.Bt + (size_t)nxt.pn * tstep : cB;
        for (int t = 0; t < nt; t += 2) {
            const bool last = (t == nt - 2);
            const char* a1 = cA + (size_t)(t + 1) * kstep;
            const char* a2 = last ? nA : cA + (size_t)(t + 2) * kstep; const char* b2 = last ? nB : cB + (size_t)(t + 2) * kstep;
            const char* a3 = a2 + kstep; const char* b3 = b2 + kstep;
            PG8_LDB(B0, 0, 0); PG8_LDB(B1, 0, 1); PG8_SCHED; PG8_LDA(At, 0, 0); PG8_STAGE(PG8_SA(1, 1), a1 + hstep, voffA);
            PG8_WAIT_V(8); PG8_WAIT_L(0); PG8_BAR; PG8_MMA(0, 0, At, B0); PG8_MMA(0, 1, At, B1); PG8_BAR; PG8_SCHED;
            PG8_LDA(At, 0, 1); PG8_STAGE(PG8_SB(0, 0), b2, voffB); PG8_STAGE(PG8_SB(0, 1), b2 + hstep, voffB); PG8_STAGE(PG8_SA(0, 0), a2, voffA);
            PG8_WAIT_V(8); PG8_WAIT_L(0); PG8_BAR; PG8_MMA(1, 0, At, B0); PG8_MMA(1, 1, At, B1); PG8_BAR; PG8_SCHED;
            PG8_LDB(B0, 1, 0); PG8_LDB(B1, 1, 1); PG8_SCHED; PG8_LDA(At, 1, 0); PG8_STAGE(PG8_SA(0, 1), a2 + hstep, voffA);
            PG8_WAIT_V(8); PG8_WAIT_L(0); PG8_BAR; PG8_MMA(0, 0, At, B0); PG8_MMA(0, 1, At, B1); PG8_BAR; PG8_SCHED;
            PG8_LDA(At, 1, 1); PG8_STAGE(PG8_SB(1, 0), b3, voffB); PG8_STAGE(PG8_SB(1, 1), b3 + hstep, voffB); PG8_STAGE(PG8_SA(1, 0), a3, voffA);
            PG8_WAIT_V(8); PG8_WAIT_L(0); PG8_BAR; PG8_MMA(1, 0, At, B0); PG8_MMA(1, 1, At, B1); PG8_BAR; PG8_SCHED;
        }
        if (wr == 0) PG8_BAR;
        { int l2 = lane; asm volatile("" : "+v"(l2)); E(acc, cur, wr, wc, l2 & 15, l2 >> 4); }
        if (!has_next) break;
#pragma unroll
        for (int a = 0; a < 2; ++a)
#pragma unroll
            for (int b = 0; b < 2; ++b)
#pragma unroll
                for (int m = 0; m < 4; ++m)
#pragma unroll
                    for (int n = 0; n < 2; ++n) acc[a][b][m][n] = (f32x4){0.f, 0.f, 0.f, 0.f};
        cur = nxt; cA = nA; cB = nB; ++ui;
        if (wr == 1) PG8_BAR;
    }
    PG8_WAIT_V(0);
    PG8_BAR;
#undef PG8_SA
#undef PG8_SB
#undef PG8_STAGE
#undef PG8_LDA
#undef PG8_LDB
#undef PG8_MMA
#undef PG8_WAIT_V
#undef PG8_WAIT_L
#undef PG8_BAR
#undef PG8_SCHED
}
}

constexpr int NWAVES = 8;
constexpr size_t MiB = 1u << 20;
constexpr size_t CTL_BYTES = 2 * MiB;
constexpr size_t CTL_BAR_B = 16384, CTL_MOD_B = 65536, CTL_STATS_B = 524288;
constexpr size_t WS_TABR = 2 * MiB, WS_TABA = 2 * MiB + 65536;
constexpr size_t WS_CK = 3 * MiB, WS_CV = 4 * MiB;
constexpr size_t WS_Q = 8 * MiB, WS_K = 56 * MiB, WS_V = 104 * MiB, WS_SGF = 200 * MiB, WS_NEED = 296 * MiB;
constexpr size_t WS_Y = 8 * MiB;
constexpr size_t WS_WO_RET = 104 * MiB, WS_WIN0 = 108 * MiB, WS_WIN1 = 119 * MiB, WS_WOUT0 = 130 * MiB, WS_WOUT1 = 135 * MiB + 512 * 1024,
                 WS_WQKV = 141 * MiB, WS_WOA = 144 * MiB;
constexpr size_t WS_H = 8 * MiB;
constexpr size_t WS_ACT = 160 * MiB;
constexpr size_t WS_AQ = 56 * MiB, WS_AK = 146 * MiB, WS_AV = 158 * MiB, WS_AO = 200 * MiB;
constexpr size_t OUT_SGB = 0;
constexpr size_t OUT_H0 = 96 * MiB, OUT_W1T = 144 * MiB;
constexpr size_t OUT_SF = (size_t)25165824 * 4, OUT_SB = (size_t)41943040 * 4, OUT_NK = (size_t)58720256 * 4, OUT_NV = (size_t)60817408 * 4;
constexpr int RING_BYTES = 131072, XCH_OFF = 131072, LDSCTL_OFF = 147456, MISC_OFF = LDSCTL_OFF + 320, INTAB_OFF = LDSCTL_OFF + 512, LDS_BYTES = 151552;

typedef GAS unsigned gu32;
#define RLX_AGENT __ATOMIC_RELAXED, __HIP_MEMORY_SCOPE_AGENT
#define PHASE_IDS() int tid_ = threadIdx.x; asm volatile("" : "+v"(tid_)); const int tid = tid_, lane = tid & 63, wid = __builtin_amdgcn_readfirstlane(tid >> 6); (void)tid; (void)lane; (void)wid; (void)0

#define XB_TMO      128
#define XB_XCNT(j)  (256  + 64 * (j))
#define XB_XSUB(j)  (1280 + 64 * (j))
#define XB_XGEN(j)  (2304 + 64 * (j))
#define XB_TOP      3328
#define XB_TOPGEN   3392
#define XCD_BAR_WORDS 3456
#define XB_SPIN_CAP (1u << 27)
__device__ __forceinline__ unsigned xb_ld(unsigned* p)              { return __hip_atomic_load(p, __ATOMIC_RELAXED, __HIP_MEMORY_SCOPE_AGENT); }
__device__ __forceinline__ unsigned xb_add(unsigned* p, unsigned v) { return __hip_atomic_fetch_add(p, v, __ATOMIC_RELAXED, __HIP_MEMORY_SCOPE_AGENT); }
__device__ __forceinline__ unsigned xb_xcc_id() { return (unsigned)__builtin_amdgcn_s_getreg((3 << 11) | 20) & 0xFu; }
#define XB_SPIN(cond, bar) do { unsigned _sp = 0; while (cond) { __builtin_amdgcn_s_sleep(1); \
    if ((++_sp & 255u) == 0u) { if (xb_ld(&(bar)[XB_TMO])) break; if (_sp > XB_SPIN_CAP) { atomicAdd(&(bar)[XB_TMO], 1u); break; } } } } while (0)
struct XcdBarrier { unsigned* bar; unsigned x; volatile LAS unsigned* st; };
__device__ __forceinline__ XcdBarrier xcd_barrier_post(unsigned* bar, volatile LAS unsigned* st) {
    XcdBarrier b; b.bar = bar; b.x = (unsigned)__builtin_amdgcn_readfirstlane((int)xb_xcc_id()); b.st = st;
    if (threadIdx.x == 0) (void)xb_add(&bar[XB_XCNT(b.x)], 1u);
    return b;
}
__device__ __forceinline__ void xcd_barrier_complete(unsigned* bar, unsigned x, unsigned& nloc, unsigned& nx) {
    const unsigned G = gridDim.x * gridDim.y * gridDim.z;
    unsigned sum, cnt, mine, sp = 0u;
    for (;;) {
        sum = 0u; cnt = 0u; mine = 0u;
#pragma unroll
        for (unsigned j = 0; j < 16; ++j) { const unsigned c = xb_ld(&bar[XB_XCNT(j)]); sum += c; cnt += (c > 0u) ? 1u : 0u; }
        if (sum == G) { mine = xb_ld(&bar[XB_XCNT(x)]); break; }
        __builtin_amdgcn_s_sleep(1);
        if ((++sp & 255u) == 0u) { if (xb_ld(&bar[XB_TMO])) break; if (sp > XB_SPIN_CAP) { atomicAdd(&bar[XB_TMO], 1u); break; } }
    }
    nloc = mine > 0u ? mine : 1u; nx = cnt > 0u ? cnt : 1u;
}
__device__ __forceinline__ void xcd_barrier(const XcdBarrier& b) {
    asm volatile("s_waitcnt vmcnt(0)" ::: "memory");
    __syncthreads();
    if (threadIdx.x == 0) {
        unsigned* bar = b.bar; unsigned bxx = b.x; asm volatile("" : "+s"(bar), "+s"(bxx));
        __builtin_amdgcn_s_waitcnt(0);
        unsigned nloc = b.st[0], nx = b.st[1];
        if (nloc == 0u) { xcd_barrier_complete(bar, bxx, nloc, nx); b.st[0] = nloc; b.st[1] = nx; }
        const unsigned old = xb_add(&bar[XB_XSUB(bxx)], 1u);
        const unsigned gen = old / nloc;
        if (old + 1u == (gen + 1u) * nloc) {
            __builtin_amdgcn_fence(__ATOMIC_RELEASE, "agent");
            asm volatile("s_waitcnt vmcnt(0)" ::: "memory");
            const unsigned og = xb_add(&bar[XB_TOP], 1u);
            const unsigned tg = og / nx;
            if (og + 1u == (tg + 1u) * nx) xb_add(&bar[XB_TOPGEN], 1u);
            else XB_SPIN(xb_ld(&bar[XB_TOPGEN]) == tg, bar);
            __builtin_amdgcn_fence(__ATOMIC_ACQUIRE, "agent");
            xb_add(&bar[XB_XGEN(bxx)], 1u);
            asm volatile("s_waitcnt vmcnt(0)" ::: "memory");
        } else {
            XB_SPIN(xb_ld(&bar[XB_XGEN(bxx)]) == gen, bar);
            __builtin_amdgcn_fence(__ATOMIC_ACQUIRE, "agent");
            asm volatile("s_waitcnt vmcnt(0)" ::: "memory");
        }
    }
    __syncthreads();
}

struct Args { const float* in[30]; float* out; unsigned char* ws; };
struct Frame {
    LAS unsigned char* lds; int vcu, G; float* out; unsigned char* ws; unsigned char* ob;
};
__device__ __forceinline__ const float* inp(const Frame& F, int i) {
    const LAS unsigned* t = (const LAS unsigned*)(F.lds + INTAB_OFF) + 2 * i; const unsigned lo = __builtin_amdgcn_readfirstlane(t[0]), hi = __builtin_amdgcn_readfirstlane(t[1]);
    return (const float*)(((unsigned long long)hi << 32) | lo); }
__device__ __forceinline__ float wave_sum(float v) {
#pragma unroll
    for (int o = 1; o < 64; o <<= 1) v += __shfl_xor(v, o);
    return v;
}

__device__ __forceinline__ int rowmap(int mode, int t) {
    if (mode == 1) { const int th = t & 255, half = th >> 7, w = th & 127, i = w & 63, hi = w >> 6; return (t & ~255) + 8 * ((half << 4) + (i >> 2)) + 4 * hi + (i & 3); }
    if (mode == 2) { const int th = t & 63, half = th >> 5, w = th & 31, i = w & 15, hi = w >> 4; return (t & ~63) + 8 * ((half << 2) + (i >> 2)) + 4 * hi + (i & 3); }
    if (mode == 3) { const int isg = t >= DFF ? 1 : 0; const int tt = isg ? t - DFF : t; return 8 * (tt >> 2) + 4 * isg + (tt & 3); }
    return t;
}
__device__ __forceinline__ void transpose_item(const float* W, int K, int N, bf16_t* WT, int row_off, int mode, LAS float* scr, int item, int lane) {
    const int nblk = N / 64, kb = item / nblk, nb = item % nblk, k0 = 64 * kb, n0 = 64 * nb;
    const int c4 = lane & 15, rr = lane >> 4;
    f32x4 v[16];
    const float* src = W + (size_t)(k0 + rr) * N + n0 + 4 * c4;
#pragma unroll
    for (int i = 0; i < 16; ++i) v[i] = *(const f32x4*)(src + (size_t)(4 * i) * N);
#pragma unroll
    for (int i = 0; i < 16; ++i) { LAS float* d = scr + (4 * i + rr) * 65 + 4 * c4; d[0] = v[i][0]; d[1] = v[i][1]; d[2] = v[i][2]; d[3] = v[i][3]; }
    asm volatile("s_waitcnt lgkmcnt(0)" ::: "memory");
    const int c = lane & 7;
#pragma unroll
    for (int j = 0; j < 8; ++j) { const int n = (lane >> 3) + 8 * j; const LAS float* s = scr + (8 * c) * 65 + n;
        u32x4 o; o.x = cvtpk(s[0 * 65], s[1 * 65]); o.y = cvtpk(s[2 * 65], s[3 * 65]); o.z = cvtpk(s[4 * 65], s[5 * 65]); o.w = cvtpk(s[6 * 65], s[7 * 65]);
        *(u32x4*)(WT + (size_t)(row_off + rowmap(mode, n0 + n)) * K + k0 + 8 * c) = o; }
    asm volatile("s_waitcnt lgkmcnt(0)" ::: "memory");
}
struct TrJob { const float* W; int K, N; bf16_t* WT; int row_off, mode, nitems; };
template <int NJ> __device__ __forceinline__ void run_transposes(const TrJob (&jobs)[NJ], LAS float* scr, int gw, int NGW, int lane) {
    int total = 0;
#pragma unroll
    for (int j = 0; j < NJ; ++j) total += jobs[j].nitems;
    for (int it = gw; it < total; it += NGW) {
        int r = it;
#pragma unroll
        for (int j = 0; j < NJ; ++j) { if (r >= 0 && r < jobs[j].nitems) { transpose_item(jobs[j].W, jobs[j].K, jobs[j].N, jobs[j].WT, jobs[j].row_off, jobs[j].mode, scr, r, lane); } r -= jobs[j].nitems; }
    }
}

__device__ __forceinline__ void p0_prologue(Frame& F) {
    PHASE_IDS();
    LAS float* scr = (LAS float*)(F.lds + wid * 16640);
    const int gw = F.vcu * NWAVES + wid, NGW = F.G * NWAVES;
    float* mod = (float*)(F.ws + CTL_MOD_B);
    { const float* cvp = inp(F, 6); const float* ccp = inp(F, 7); const float* wbase = inp(F, 8); const float* bbase = inp(F, 9);
    for (int it = gw; it < 1536; it += NGW) {
        const int kq = it & 7, jb = (it >> 3) % 96, l = it / 768, j0 = jb * 64; const float* W = wbase + ((size_t)l * 1024 + kq * 128) * 6144 + j0 + lane;
        float acc[9]; const float bias = kq == 0 ? bbase[l * 6144 + j0 + lane] : 0.0f;
#pragma unroll
        for (int mb = 0; mb < 9; ++mb) acc[mb] = bias;
#pragma unroll 1
        for (int kb = 0; kb < 2; ++kb) {
            float sreg[9];
#pragma unroll
            for (int mb = 0; mb < 9; ++mb) { const float cv = mb < 8 ? cvp[mb * 1024 + kq * 128 + kb * 64 + lane] : ccp[kq * 128 + kb * 64 + lane]; sreg[mb] = cv / (1.0f + expf(-cv)); }
            float wv[64];
#pragma unroll
            for (int kk = 0; kk < 64; ++kk) wv[kk] = W[(size_t)(kb * 64 + kk) * 6144];
#pragma unroll
            for (int kk = 0; kk < 64; ++kk) {
#pragma unroll
                for (int mb = 0; mb < 9; ++mb) acc[mb] += __uint_as_float(__builtin_amdgcn_readlane(__float_as_uint(sreg[mb]), kk)) * wv[kk]; }
        }
#pragma unroll
        for (int mb = 0; mb < 9; ++mb) atomicAdd(mod + (l * 9 + mb) * 6144 + j0 + lane, acc[mb]);
    } }
    { float* tr = (float*)(F.ws + WS_TABR); float* ta = (float*)(F.ws + WS_TABA);
      for (int e = gw * 64 + lane; e < 4096 + 1024; e += NGW * 64) {
          if (e < 4096) { const int pos = e >> 6, i = e & 63; const float inv = powf(10000.0f, -(float)i / 64.0f); const float ang = (float)pos * inv; tr[2 * e] = cosf(ang); tr[2 * e + 1] = sinf(ang); }
          else { const int e2 = e - 4096, pos = e2 >> 4, i = e2 & 15; const float inv = powf(10000.0f, -(float)i / 16.0f); const float ang = (float)pos * inv; ta[2 * e2] = cosf(ang); ta[2 * e2 + 1] = sinf(ang); } } }
    { bf16_t* ck = (bf16_t*)(F.ws + WS_CK); bf16_t* cv = (bf16_t*)(F.ws + WS_CV);
      for (int e = (gw * 64 + lane) * 4; e < 524288; e += NGW * 64 * 4) {
          const f32x4 a = *(const f32x4*)(inp(F, 4) + e), b = *(const f32x4*)(inp(F, 5) + e);
          u32x2 wa = {cvtpk(a[0], a[1]), cvtpk(a[2], a[3])}, wb = {cvtpk(b[0], b[1]), cvtpk(b[2], b[3])};
          *(u32x2*)(ck + e) = wa; *(u32x2*)(cv + e) = wb; } }
    { bf16_t* w1t = (bf16_t*)(F.ob + OUT_W1T);
      const TrJob jobs[5] = { {inp(F, 12), 1024, 1024, w1t, 0, 1, 256}, {inp(F, 13), 1024, 1024, w1t, 1024, 1, 256}, {inp(F, 14), 1024, 2048, w1t, 2048, 0, 512},
                              {inp(F, 15), 1024, 2048, w1t, 4096, 0, 512}, {inp(F, 16), 1024, 2048, w1t, 6144, 0, 512} };
      run_transposes<5>(jobs, scr, gw, NGW, lane); }
}

__device__ __forceinline__ void modulate_rows(Frame& F, const float* xa, const float* xb, const float* g, const float* modl, int shc, int scc, bf16_t* Hout) {
    PHASE_IDS();
    const int gw = F.vcu * NWAVES + wid, NGW = F.G * NWAVES;
    for (int row0 = gw; row0 < MROWS; row0 += 2 * NGW) {
        const int row1 = row0 + NGW < MROWS ? row0 + NGW : row0;
        const float* s0p = row0 < NCTX ? xa + (size_t)row0 * 1024 : xb + (size_t)(row0 - NCTX) * 1024;
        const float* s1p = row1 < NCTX ? xa + (size_t)row1 * 1024 : xb + (size_t)(row1 - NCTX) * 1024;
        f32x4 v0[4], v1[4];
#pragma unroll
        for (int j = 0; j < 4; ++j) { v0[j] = *(const f32x4*)(s0p + 4 * (lane + 64 * j)); v1[j] = *(const f32x4*)(s1p + 4 * (lane + 64 * j)); }
#pragma unroll
        for (int rr = 0; rr < 2; ++rr) {
            const int row = rr ? row1 : row0; const int mb = row < NCTX ? 8 : ((row - NCTX) >> 11);
            float ss = 0.f;
#pragma unroll
            for (int j = 0; j < 4; ++j) { const f32x4 t = rr ? v1[j] : v0[j]; ss += (t[0] * t[0] + t[1] * t[1]) + (t[2] * t[2] + t[3] * t[3]); }
            const float rstd = 1.0f / sqrtf(wave_sum(ss) * (1.0f / 1024.0f) + EPSV);
            const float* sh = modl + mb * 6144 + shc * 1024; const float* sc = modl + mb * 6144 + scc * 1024;
            if (rr == 0 || row1 != row0) {
#pragma unroll
            for (int j = 0; j < 4; ++j) { const int col = 4 * (lane + 64 * j); const f32x4 gg = *(const f32x4*)(g + col), s1 = *(const f32x4*)(sc + col), s0 = *(const f32x4*)(sh + col);
                const f32x4 t = rr ? v1[j] : v0[j]; const f32x4 y = (t * rstd) * gg * (1.0f + s1) + s0; u32x2 w = {cvtpk(y[0], y[1]), cvtpk(y[2], y[3])}; *(u32x2*)(Hout + (size_t)row * 1024 + col) = w; } }
        }
    }
}
__device__ __forceinline__ void final_norm(Frame& F, float* Xp, const float* g) {
    PHASE_IDS();
    const int gw = F.vcu * NWAVES + wid, NGW = F.G * NWAVES;
    for (int row0 = gw; row0 < MROWS; row0 += 2 * NGW) {
        const int row1 = row0 + NGW < MROWS ? row0 + NGW : row0;
        float* s0p = Xp + (size_t)row0 * 1024; float* s1p = Xp + (size_t)row1 * 1024;
        f32x4 v0[4], v1[4];
#pragma unroll
        for (int j = 0; j < 4; ++j) { v0[j] = *(const f32x4*)(s0p + 4 * (lane + 64 * j)); v1[j] = *(const f32x4*)(s1p + 4 * (lane + 64 * j)); }
#pragma unroll
        for (int rr = 0; rr < 2; ++rr) {
            float ss = 0.f;
#pragma unroll
            for (int j = 0; j < 4; ++j) { const f32x4 t = rr ? v1[j] : v0[j]; ss += (t[0] * t[0] + t[1] * t[1]) + (t[2] * t[2] + t[3] * t[3]); }
            const float rstd = 1.0f / sqrtf(wave_sum(ss) * (1.0f / 1024.0f) + EPSV);
            if (rr == 0 || row1 != row0) {
#pragma unroll
            for (int j = 0; j < 4; ++j) { const int col = 4 * (lane + 64 * j); const f32x4 gg = *(const f32x4*)(g + col); const f32x4 t = rr ? v1[j] : v0[j]; *(f32x4*)((rr ? s1p : s0p) + col) = (t * rstd) * gg; } }
        }
    }
}

__device__ __forceinline__ s16x4 vtr(const LAS unsigned char* p) { return __builtin_bit_cast(s16x4, __builtin_amdgcn_ds_read_tr16_b64_v4i16((LAS v4i16_t*)p)); }
__device__ __forceinline__ bf16x8 cat8(s16x4 lo, s16x4 hi) { return __builtin_shufflevector(lo, hi, 0, 1, 2, 3, 4, 5, 6, 7); }
__device__ __forceinline__ bf16x8 pack8(const f32x16& x, int s) {
    u32x4 p; p.x = cvtpk(x[8 * s], x[8 * s + 1]); p.y = cvtpk(x[8 * s + 2], x[8 * s + 3]); p.z = cvtpk(x[8 * s + 4], x[8 * s + 5]); p.w = cvtpk(x[8 * s + 6], x[8 * s + 7]);
    return __builtin_bit_cast(bf16x8, p);
}
constexpr int R_QT = 0, R_KT = 18432, R_VT = 36864, R_PT = 71680, R_VZ = 106496;
constexpr int R_QS = 144, R_VS = 272;
__device__ __forceinline__ void retention_item(Frame& F, int type, int b, int h, int dir, int sl, bool dry = false) {
    PHASE_IDS();
    const int g = wid >> 2, w = wid & 3;
    LAS unsigned char* L = F.lds;
    const bf16_t* Qg = (const bf16_t*)(F.ws + WS_Q); const bf16_t* Kg = (const bf16_t*)(F.ws + WS_K); const bf16_t* Vg = (const bf16_t*)(F.ws + WS_V);
    bf16_t* SG = dir ? (bf16_t*)(F.ob + OUT_SGB) : (bf16_t*)(F.ws + WS_SGF);
    float* stats = (float*)(F.ws + CTL_STATS_B);
    const int nch = type ? 16 : 2, rowbase = type ? NCTX + b * 2048 : b * 256;
    const float raw = (dir ? inp(F, 19) : inp(F, 18))[h];
    const float lg2_ = -log1pf(expf(-raw)) * LOG2E;
    const int jt = wid >> 1, it0 = 2 * (wid & 1);
    f32x16 st[4];
    { const int n = lane & 31, h5 = lane >> 5;
      const float* S0 = (dir ? inp(F, 3) : inp(F, 2)) + (size_t)(b * 4 + h) * 256 * 512 + sl * 128 + 32 * w + n;
#pragma unroll
      for (int d = 0; d < 4; ++d)
#pragma unroll
          for (int r = 0; r < 16; ++r) st[d][r] = type ? S0[(size_t)(64 * d + 32 * g + crow(r, h5)) * 512] : 0.0f; }
    for (int cc = 0; cc < nch; ++cc) {
        const int c = dir ? nch - 1 - cc : cc; const int R0 = rowbase + 128 * c;
        int tl = tid; float lg2 = lg2_; asm volatile("" : "+v"(tl), "+v"(lg2));
        const int tid = tl, lane = tl & 63, n = lane & 31, h5 = lane >> 5, blk = (lane >> 4) & 1, q4 = (lane & 15) >> 2, p4 = lane & 3;
        const float g128 = exp2f(lg2 * 128.0f);
        f32x16 oacc[4], X0, X1;
#pragma unroll
        for (int i = 0; i < 16; ++i) { oacc[0][i] = 0.f; oacc[1][i] = 0.f; oacc[2][i] = 0.f; oacc[3][i] = 0.f; X0[i] = 0.f; X1[i] = 0.f; }
#pragma unroll
        for (int d = 0; d < 4; ++d) {
            __syncthreads();
            if (d == 0) {
                const int j = tid >> 2, pc = tid & 3; const bf16_t* src = Vg + (size_t)(R0 + j) * 2048 + h * 512 + sl * 128 + pc * 32;
                const float pj = (float)(dir ? 127 - j : j); const float zeta = exp2f(lg2 * (127.0f - pj));
#pragma unroll
                for (int ii = 0; ii < 4; ++ii) { const u32x4 vv = *(const u32x4*)(src + 8 * ii);
                    *(LAS u32x4*)(L + R_VT + j * R_VS + pc * 64 + 16 * ii) = vv;
                    u32x4 z; z.x = cvtpk(bflo(vv.x) * zeta, bfhi(vv.x) * zeta); z.y = cvtpk(bflo(vv.y) * zeta, bfhi(vv.y) * zeta); z.z = cvtpk(bflo(vv.z) * zeta, bfhi(vv.z) * zeta); z.w = cvtpk(bflo(vv.w) * zeta, bfhi(vv.w) * zeta);
                    *(LAS u32x4*)(L + R_VZ + j * R_VS + pc * 64 + 16 * ii) = z; }
            }
            { const int j = tid >> 2, pc = tid & 3; const size_t go = (size_t)(R0 + j) * 1024 + h * 256 + 64 * d + pc * 16;
              const u32x4 q0 = *(const u32x4*)(Qg + go), q1 = *(const u32x4*)(Qg + go + 8), k0 = *(const u32x4*)(Kg + go), k1 = *(const u32x4*)(Kg + go + 8);
              *(LAS u32x4*)(L + R_QT + j * R_QS + pc * 32) = q0; *(LAS u32x4*)(L + R_QT + j * R_QS + pc * 32 + 16) = q1;
              *(LAS u32x4*)(L + R_KT + j * R_QS + pc * 32) = k0; *(LAS u32x4*)(L + R_KT + j * R_QS + pc * 32 + 16) = k1; }
            __syncthreads();
#pragma unroll 1
            for (int s = 0; s < 4; ++s) {
                const bf16x8 a = *(const LAS bf16x8*)(L + R_KT + (32 * jt + n) * R_QS + (16 * s + 8 * h5) * 2);
                const bf16x8 b0 = *(const LAS bf16x8*)(L + R_QT + (32 * it0 + n) * R_QS + (16 * s + 8 * h5) * 2);
                const bf16x8 b1 = *(const LAS bf16x8*)(L + R_QT + (32 * (it0 + 1) + n) * R_QS + (16 * s + 8 * h5) * 2);
                X0 = MFMA32(a, b0, X0); X1 = MFMA32(a, b1, X1);
                PINV(X0); PINV(X1); FENCE();
            }
            FENCE();
#pragma unroll
            for (int s = 0; s < 2; ++s) {
                const bf16x8 bfr = pack8(st[d], s);
#pragma unroll
                for (int it = 0; it < 4; ++it) {
                    const LAS unsigned char* qp = L + R_QT + (32 * it + n) * R_QS + (32 * g + 16 * s + 4 * h5) * 2;
                    const s16x4 lo = *(const LAS s16x4*)qp, hi = *(const LAS s16x4*)(qp + 16);
                    oacc[it] = MFMA32(cat8(lo, hi), bfr, oacc[it]);
                    PINV(oacc[it]); FENCE();
                }
            }
#pragma unroll
            for (int r = 0; r < 16; ++r) st[d][r] *= g128;
            FENCE();
#pragma unroll 1
            for (int ks = 0; ks < 8; ++ks) {
                const int rowb = 16 * ks + 8 * h5 + q4;
                const LAS unsigned char* ka = L + R_KT + rowb * R_QS + (32 * g + 16 * blk) * 2 + 8 * p4;
                const LAS unsigned char* vb = L + R_VZ + rowb * R_VS + (32 * w + 16 * blk) * 2 + 8 * p4;
                const bf16x8 af = cat8(vtr(ka), vtr(ka + 4 * R_QS)), bfv = cat8(vtr(vb), vtr(vb + 4 * R_VS));
                st[d] = MFMA32(af, bfv, st[d]);
                PINV(st[d]); FENCE();
            }
        }
#pragma unroll
        for (int it = 0; it < 4; ++it)
#pragma unroll
            for (int r = 0; r < 16; ++r) { const int i = 32 * it + crow(r, h5); const float pi = (float)(dir ? 127 - i : i); oacc[it][r] *= exp2f(lg2 * (pi + 1.0f)); }
#pragma unroll
        for (int tt = 0; tt < 2; ++tt) {
            const int i = 32 * (it0 + tt) + n; const int pi = dir ? 127 - i : i;
#pragma unroll
            for (int r4 = 0; r4 < 4; ++r4) { const int j0 = 32 * jt + 8 * r4 + 4 * h5; float vv[4];
#pragma unroll
                for (int e = 0; e < 4; ++e) { const int j = j0 + e; const int pj = dir ? 127 - j : j; const int dd = pi - pj; const float x = tt ? X1[4 * r4 + e] : X0[4 * r4 + e];
                    vv[e] = dd >= 0 ? x * exp2f(lg2 * (float)dd) : 0.0f; }
                u32x2 wv = {cvtpk(vv[0], vv[1]), cvtpk(vv[2], vv[3])};
                *(LAS u32x2*)(L + R_PT + i * R_VS + j0 * 2) = wv; }
        }
        __syncthreads();
#pragma unroll 1
        for (int ks = 0; ks < 4; ++ks) {
            const int k0 = 64 * g + 16 * ks; const int rowb = k0 + 8 * h5 + q4;
            const LAS unsigned char* vb = L + R_VT + rowb * R_VS + (32 * w + 16 * blk) * 2 + 8 * p4;
            const bf16x8 bfv = cat8(vtr(vb), vtr(vb + 4 * R_VS));
#pragma unroll
            for (int it = 0; it < 4; ++it) { const bf16x8 af = *(const LAS bf16x8*)(L + R_PT + (32 * it + n) * R_VS + (k0 + 8 * h5) * 2); oacc[it] = MFMA32(af, bfv, oacc[it]); }
            PINV(oacc[0]); PINV(oacc[1]); PINV(oacc[2]); PINV(oacc[3]); FENCE();
        }
        __syncthreads();
        LAS float* XB = (LAS float*)(L + R_PT);
        if (g == 1) {
#pragma unroll
            for (int it = 0; it < 4; ++it)
#pragma unroll
                for (int r = 0; r < 16; ++r) XB[w * 4096 + (32 * it + crow(r, h5)) * 32 + n] = oacc[it][r];
        }
        __syncthreads();
        if (g == 0) {
#pragma unroll
            for (int it = 0; it < 4; ++it)
#pragma unroll
                for (int r = 0; r < 16; ++r) { LAS float* p = XB + w * 4096 + (32 * it + crow(r, h5)) * 32 + n; *p = *p + oacc[it][r]; }
        }
        __syncthreads();
        { const int i = tid >> 2, w2 = tid & 3; const LAS f32x4* p = (const LAS f32x4*)(XB + w2 * 4096 + i * 32);
          f32x4 o[8]; float ss = 0.f;
#pragma unroll
          for (int e = 0; e < 8; ++e) { o[e] = p[e]; ss += (o[e][0] * o[e][0] + o[e][1] * o[e][1]) + (o[e][2] * o[e][2] + o[e][3] * o[e][3]); }
          ss += __shfl_xor(ss, 1); ss += __shfl_xor(ss, 2);
          if (w2 == 0 && !dry) atomicAdd(stats + ((size_t)(R0 + i) * 4 + h) * 2 + dir, ss);
          bf16_t* zp = SG + (size_t)(R0 + i) * 2048 + h * 512 + sl * 128 + 32 * w2;
#pragma unroll
          for (int e = 0; e < 4; ++e) { const u32x4 gv = *(const u32x4*)(zp + 8 * e); const f32x4 a = o[2 * e], c2 = o[2 * e + 1]; u32x4 z;
              z.x = cvtpk(a[0] * bflo(gv.x), a[1] * bfhi(gv.x)); z.y = cvtpk(a[2] * bflo(gv.y), a[3] * bfhi(gv.y));
              z.z = cvtpk(c2[0] * bflo(gv.z), c2[1] * bfhi(gv.z)); z.w = cvtpk(c2[2] * bflo(gv.w), c2[3] * bfhi(gv.w));
              if (!dry) *(u32x4*)(zp + 8 * e) = z; } }
    }
    if (type == 0) {
        const int n = lane & 31, h5 = lane >> 5;
        float* So = (float*)(F.ob + (dir ? OUT_SB : OUT_SF)) + (size_t)(b * 4 + h) * 256 * 512 + sl * 128 + 32 * w + n;
#pragma unroll
        for (int d = 0; d < 4; ++d)
#pragma unroll
            for (int r = 0; r < 16; ++r) So[(size_t)(64 * d + 32 * g + crow(r, h5)) * 512] = st[d][r];
    }
}
__device__ __forceinline__ void retention_phase(Frame& F, bool dry = false) {
    for (int it = F.vcu; it < 1280; it += F.G) {
        if (it < 256) retention_item(F, 1, it >> 5, (it >> 3) & 3, (it >> 2) & 1, it & 3, dry);
        else { const int i2 = it - 256; retention_item(F, 0, i2 >> 5, (i2 >> 3) & 3, (i2 >> 2) & 1, i2 & 3, dry); }
    }
}
__device__ __forceinline__ void combine_rows(Frame& F) {
    PHASE_IDS();
    const int gw = F.vcu * NWAVES + wid, NGW = F.G * NWAVES;
    const bf16_t* zf = (const bf16_t*)(F.ws + WS_SGF); const bf16_t* zb = (const bf16_t*)(F.ob + OUT_SGB); bf16_t* Y = (bf16_t*)(F.ws + WS_Y);
    const float* stats = (const float*)(F.ws + CTL_STATS_B);
    for (int row0 = gw; row0 < MROWS; row0 += 2 * NGW) {
        const int row1 = row0 + NGW < MROWS ? row0 + NGW : row0; const int h = lane >> 4;
        u32x4 a[2][4], c[2][4]; float sf[2], sb[2];
#pragma unroll
        for (int rr = 0; rr < 2; ++rr) { const int row = rr ? row1 : row0; const size_t off = (size_t)row * 2048 + lane * 32;
            sf[rr] = stats[((size_t)row * 4 + h) * 2]; sb[rr] = stats[((size_t)row * 4 + h) * 2 + 1];
#pragma unroll
            for (int e = 0; e < 4; ++e) { a[rr][e] = *(const u32x4*)(zf + off + 8 * e); c[rr][e] = *(const u32x4*)(zb + off + 8 * e); } }
#pragma unroll
        for (int rr = 0; rr < 2; ++rr) { const int row = rr ? row1 : row0; const size_t off = (size_t)row * 2048 + lane * 32;
            const float rf = 1.0f / sqrtf(sf[rr] * (1.0f / 512.0f) + EPSV), rb = 1.0f / sqrtf(sb[rr] * (1.0f / 512.0f) + EPSV);
            if (rr == 0 || row1 != row0) {
#pragma unroll
            for (int e = 0; e < 4; ++e) { const u32x4 p = a[rr][e], q = c[rr][e]; u32x4 y;
                y.x = cvtpk(rf * bflo(p.x) + rb * bflo(q.x), rf * bfhi(p.x) + rb * bfhi(q.x)); y.y = cvtpk(rf * bflo(p.y) + rb * bflo(q.y), rf * bfhi(p.y) + rb * bfhi(q.y));
                y.z = cvtpk(rf * bflo(p.z) + rb * bflo(q.z), rf * bfhi(p.z) + rb * bfhi(q.z)); y.w = cvtpk(rf * bflo(p.w) + rb * bflo(q.w), rf * bfhi(p.w) + rb * bfhi(q.w));
                *(u32x4*)(Y + off + 8 * e) = y; } }
        }
    }
}

constexpr int A_KT = 0, A_VT = 9216, A_WS = 18432, A_RS = 144;
__device__ __forceinline__ void attn_item(Frame& F, int type, int b, int kh, int qb) {
    PHASE_IDS();
    const int n = lane & 31, h5 = lane >> 5, blk = (lane >> 4) & 1, q4 = (lane & 15) >> 2, p4 = lane & 3;
    LAS unsigned char* L = F.lds; LAS float* wsf = (LAS float*)(L + A_WS) + wid * 32;
    const bf16_t* AQ = (const bf16_t*)(F.ws + WS_AQ); const bf16_t* AK = (const bf16_t*)(F.ws + WS_AK); const bf16_t* AV = (const bf16_t*)(F.ws + WS_AV);
    const bf16_t* CK = (const bf16_t*)(F.ws + WS_CK); const bf16_t* CV = (const bf16_t*)(F.ws + WS_CV); bf16_t* AO = (bf16_t*)(F.ws + WS_AO);
    const int gq = wid >> 1, rh = wid & 1, head = kh * 4 + gq;
    const int seq0 = type ? NCTX + b * 2048 : b * 256; const int qrow0 = seq0 + 64 * qb;
    bf16x8 qf[4];
#pragma unroll
    for (int s = 0; s < 4; ++s) qf[s] = *(const bf16x8*)(AQ + (size_t)(qrow0 + 32 * rh + n) * 1024 + head * 64 + 16 * s + 8 * h5);
    float mrun = -1e30f, lrun = 0.f; f32x16 o0, o1;
#pragma unroll
    for (int i = 0; i < 16; ++i) { o0[i] = 0.f; o1[i] = 0.f; }
    int blo = 0, bhi = -1;
    if (type) { blo = qb - 2 < 0 ? 0 : qb - 2; bhi = qb + 2 > 31 ? 31 : qb + 2; }
    const int ntile = 4 + (type ? bhi - blo + 1 : 0);
    for (int t = 0; t < ntile; ++t) {
        const bool band = t >= 4; const int kt = band ? blo + (t - 4) : t;
        const bf16_t *ks, *vs;
        if (type == 0) { ks = AK + (size_t)(seq0 + 64 * kt) * 256 + kh * 64; vs = AV + (size_t)(seq0 + 64 * kt) * 256 + kh * 64; }
        else if (!band) { ks = CK + (size_t)(b * 256 + 64 * kt) * 256 + kh * 64; vs = CV + (size_t)(b * 256 + 64 * kt) * 256 + kh * 64; }
        else { ks = AK + (size_t)(seq0 + 64 * kt) * 256 + kh * 64; vs = AV + (size_t)(seq0 + 64 * kt) * 256 + kh * 64; }
        __syncthreads();
        { const int j = tid >> 3, pc = tid & 7; const u32x4 kv = *(const u32x4*)(ks + (size_t)j * 256 + pc * 8), vv = *(const u32x4*)(vs + (size_t)j * 256 + pc * 8);
          *(LAS u32x4*)(L + A_KT + j * A_RS + pc * 16) = kv; *(LAS u32x4*)(L + A_VT + j * A_RS + pc * 16) = vv; }
        __syncthreads();
        f32x16 p0, p1;
#pragma unroll
        for (int i = 0; i < 16; ++i) { p0[i] = 0.f; p1[i] = 0.f; }
#pragma unroll
        for (int s = 0; s < 4; ++s) {
            const bf16x8 a0 = *(const LAS bf16x8*)(L + A_KT + n * A_RS + (16 * s + 8 * h5) * 2), a1 = *(const LAS bf16x8*)(L + A_KT + (32 + n) * A_RS + (16 * s + 8 * h5) * 2);
            p0 = MFMA32(a0, qf[s], p0); p1 = MFMA32(a1, qf[s], p1);
        }
        if (band) { const int qp = 64 * qb + 32 * rh + n;
#pragma unroll
            for (int r = 0; r < 16; ++r) { const int kp = 64 * kt + crow(r, h5); int d0 = qp - kp; d0 = d0 < 0 ? -d0 : d0; int d1 = qp - kp - 32; d1 = d1 < 0 ? -d1 : d1;
                if (d0 > 128) p0[r] = -1e30f; if (d1 > 128) p1[r] = -1e30f; } }
        float mx = p0[0];
#pragma unroll
        for (int r = 0; r < 16; ++r) { mx = fmaxf(mx, p0[r]); mx = fmaxf(mx, p1[r]); }
        mx = fmaxf(mx, __shfl_xor(mx, 32));
        const float mnew = fmaxf(mrun, mx); const float f = exp2f(mrun - mnew); mrun = mnew;
        float ls = 0.f;
#pragma unroll
        for (int r = 0; r < 16; ++r) { p0[r] = exp2f(p0[r] - mnew); p1[r] = exp2f(p1[r] - mnew); ls += p0[r] + p1[r]; }
        ls += __shfl_xor(ls, 32);
        lrun = lrun * f + ls;
        if (h5 == 0) wsf[n] = f;
        asm volatile("s_waitcnt lgkmcnt(0)" ::: "memory");
#pragma unroll
        for (int r = 0; r < 16; ++r) { const float fr_ = wsf[crow(r, h5)]; o0[r] *= fr_; o1[r] *= fr_; }
        asm volatile("s_waitcnt lgkmcnt(0)" ::: "memory");
#pragma unroll
        for (int tk = 0; tk < 2; ++tk)
#pragma unroll
            for (int s = 0; s < 2; ++s) {
                const bf16x8 af = tk ? pack8(p1, s) : pack8(p0, s);
                const int rowb = 32 * tk + 16 * s + 4 * h5 + q4;
                const LAS unsigned char* vb = L + A_VT + rowb * A_RS + (16 * blk) * 2 + 8 * p4;
                o0 = MFMA32(af, cat8(vtr(vb), vtr(vb + 8 * A_RS)), o0);
                o1 = MFMA32(af, cat8(vtr(vb + 64), vtr(vb + 64 + 8 * A_RS)), o1);
            }
    }
    lrun += exp2f(inp(F, 24)[head] * LOG2E - mrun);
    const float inv = 1.0f / lrun;
    if (h5 == 0) wsf[n] = inv;
    asm volatile("s_waitcnt lgkmcnt(0)" ::: "memory");
#pragma unroll
    for (int r = 0; r < 16; ++r) { const float iv = wsf[crow(r, h5)]; bf16_t* op = AO + (size_t)(qrow0 + 32 * rh + crow(r, h5)) * 1024 + head * 64 + n;
        op[0] = (bf16_t)(cvtpk(o0[r] * iv, 0.f) & 0xffffu); op[32] = (bf16_t)(cvtpk(o1[r] * iv, 0.f) & 0xffffu); }
    asm volatile("s_waitcnt lgkmcnt(0)" ::: "memory");
}
__device__ __forceinline__ void attn_phase(Frame& F) {
    for (int it = F.vcu; it < 1536; it += F.G) {
        if (it < 1024) attn_item(F, 1, it >> 7, (it >> 5) & 3, it & 31);
        else { const int i2 = it - 1024; attn_item(F, 0, i2 >> 4, (i2 >> 2) & 3, i2 & 3); }
    }
}

__global__ void __launch_bounds__(NWAVES * 64, 2) mega_fwd(Args args) {
    extern __shared__ __attribute__((aligned(16))) unsigned char lds_raw[];
    Frame F;
    F.lds = (LAS unsigned char*)lds_raw;
    volatile LAS unsigned* MISC = (volatile LAS unsigned*)(F.lds + MISC_OFF);
    F.G = gridDim.x; { const int bx = blockIdx.x; F.vcu = (F.G % 8 == 0) ? (bx % 8) * (F.G / 8) + bx / 8 : bx; }
    F.out = args.out; F.ws = args.ws; F.ob = (unsigned char*)args.out;
    for (int u = threadIdx.x; u < (LDS_BYTES - LDSCTL_OFF) / 4; u += NWAVES * 64) ((LAS unsigned*)(F.lds + LDSCTL_OFF))[u] = 0u;
    __syncthreads();
    if (threadIdx.x == 0) {
#pragma unroll
        for (int i = 0; i < 30; ++i) ((LAS unsigned long long*)(F.lds + INTAB_OFF))[i] = (unsigned long long)args.in[i];
    }
    __syncthreads();
    XcdBarrier bar = xcd_barrier_post((unsigned*)(F.ws + CTL_BAR_B), MISC + 8);
#define GRID_BAR() do { xcd_barrier(bar); asm volatile("" : "+s"(F.ws), "+s"(F.ob), "+s"(F.vcu), "+s"(F.G), "+s"(bx)); } while (0)
#define mod ((float*)(F.ws + CTL_MOD_B))
#define X ((float*)F.ob)
#define H ((bf16_t*)(F.ws + WS_H))
    int bx = (int)blockIdx.x;

#ifndef NO_P0
    p0_prologue(F);
#endif
    GRID_BAR();
#if PROBE_DUP == 1
    p0_prologue(F); GRID_BAR();
#endif
    modulate_rows(F, inp(F, 0), inp(F, 1), inp(F, 10), mod, 0, 1, (bf16_t*)(F.ob + OUT_H0)); GRID_BAR();
    { pg8::Gemm g{(const bf16_t*)(F.ob + OUT_H0), (const bf16_t*)(F.ob + OUT_W1T), 1024}; pg8::TileOrder S; S.init(96, 32, F.G, bx, 0);
      pg8::EpiRet E{(bf16_t*)(F.ws + WS_Q), (bf16_t*)(F.ws + WS_K), (bf16_t*)(F.ws + WS_V), (bf16_t*)(F.ws + WS_SGF), (bf16_t*)(F.ob + OUT_SGB), (const float*)(F.ws + WS_TABR)};
      pg8::gemm_phase(F.lds, g, S, E); }
    GRID_BAR();
#if PROBE_DUP == 2
    retention_phase(F, true); GRID_BAR();
#endif
#ifndef NO_RET
    retention_phase(F);
#endif
    GRID_BAR();
    for (int rep_ = 0; rep_ < (PROBE_DUP == 4 ? 2 : 1); ++rep_)
    { combine_rows(F);
      PHASE_IDS();
      LAS float* scr = (LAS float*)(F.lds + wid * 16640); const int gw = F.vcu * NWAVES + wid, NGW = F.G * NWAVES;
      bf16_t* wqkv = (bf16_t*)(F.ws + WS_WQKV);
      const TrJob jobs[10] = { {inp(F, 17), 2048, 1024, (bf16_t*)(F.ws + WS_WO_RET), 0, 0, 512},
                               {inp(F, 25), 1024, 5632, (bf16_t*)(F.ws + WS_WIN0), 0, 3, 1408}, {inp(F, 25) + (size_t)1024 * 5632, 1024, 5632, (bf16_t*)(F.ws + WS_WIN1), 0, 3, 1408},
                               {inp(F, 28), 2816, 1024, (bf16_t*)(F.ws + WS_WOUT0), 0, 0, 704}, {inp(F, 28) + (size_t)2816 * 1024, 2816, 1024, (bf16_t*)(F.ws + WS_WOUT1), 0, 0, 704},
                               {inp(F, 20), 1024, 1024, wqkv, 0, 2, 256}, {inp(F, 21), 1024, 256, wqkv, 1024, 2, 64}, {inp(F, 22), 1024, 256, wqkv, 1280, 0, 64},
                               {inp(F, 23), 1024, 1024, (bf16_t*)(F.ws + WS_WOA), 0, 0, 256}, {nullptr, 0, 64, nullptr, 0, 0, 0} };
#ifndef NO_P4T
      run_transposes<10>(jobs, scr, gw, NGW, lane);
#endif
    }
    GRID_BAR();
    { pg8::Gemm g{(const bf16_t*)(F.ws + WS_Y), (const bf16_t*)(F.ws + WS_WO_RET), 2048}; pg8::TileOrder S; S.init(96, 4, F.G, bx, 0);
      pg8::EpiResid E{inp(F, 0), inp(F, 1), X, mod + 2 * 1024};
      pg8::gemm_phase(F.lds, g, S, E); }
    GRID_BAR();
#pragma unroll 1
    for (int l = 0; l < 2; ++l) {
        const float* modl = mod + l * 9 * 6144;
        if (l == 1) {
            modulate_rows(F, X, X + (size_t)NCTX * 1024, inp(F, 10) + 1024, modl, 0, 1, H); GRID_BAR();
            { pg8::Gemm g{H, (const bf16_t*)(F.ws + WS_WQKV), 1024}; pg8::TileOrder S; S.init(96, 6, F.G, bx, 0);
              pg8::EpiAttnQKV E{(bf16_t*)(F.ws + WS_AQ), (bf16_t*)(F.ws + WS_AK), (bf16_t*)(F.ws + WS_AV), (float*)(F.ob + OUT_NK), (float*)(F.ob + OUT_NV), (const float*)(F.ws + WS_TABA)};
              pg8::gemm_phase(F.lds, g, S, E); }
            GRID_BAR();
#ifndef NO_ATTN
            attn_phase(F);
#endif
            GRID_BAR();
#if PROBE_DUP == 3
            attn_phase(F); GRID_BAR();
#endif
            { pg8::Gemm g{(const bf16_t*)(F.ws + WS_AO), (const bf16_t*)(F.ws + WS_WOA), 1024}; pg8::TileOrder S; S.init(96, 4, F.G, bx, 0);
              pg8::EpiResid E{X, X + (size_t)NCTX * 1024, X, modl + 2 * 1024};
              pg8::gemm_phase(F.lds, g, S, E); }
            GRID_BAR();
        }
        modulate_rows(F, X, X + (size_t)NCTX * 1024, inp(F, 11) + l * 1024, modl, 3, 4, H); GRID_BAR();
        { pg8::Gemm g{H, (const bf16_t*)(F.ws + (l ? WS_WIN1 : WS_WIN0)), 1024}; pg8::TileOrder S; S.init(104, 22, F.G, bx, 1);
          pg8::EpiFfn E{(bf16_t*)(F.ws + WS_ACT), inp(F, 26) + (size_t)l * 3 * 5632, inp(F, 27) + (size_t)l * 5632, (LAS float*)(F.lds + XCH_OFF)};
#ifndef NO_FFN
          pg8::gemm_phase(F.lds, g, S, E);
#endif
        }
        GRID_BAR();
        { pg8::Gemm g{(const bf16_t*)(F.ws + WS_ACT), (const bf16_t*)(F.ws + (l ? WS_WOUT1 : WS_WOUT0)), 2816}; pg8::TileOrder S; S.init(96, 4, F.G, bx, 0);
          pg8::EpiResid E{X, X + (size_t)NCTX * 1024, X, modl + 5 * 1024};
          pg8::gemm_phase(F.lds, g, S, E); }
        GRID_BAR();
    }
    final_norm(F, X, inp(F, 29));
#undef mod
#undef X
#undef H
}

extern "C" void kernel_launch(void* const* d_in, const int* in_sizes, int n_in, void* d_out, int out_size, void* d_ws, size_t ws_size, hipStream_t stream) {
    static int grid = 0;
    if (grid == 0) {
        if (n_in != 30 || out_size != 62914560 || ws_size < WS_NEED) { fprintf(stderr, "kernel_launch: unexpected problem: n_in %d out %d ws %zu (need %zu)\n", n_in, out_size, ws_size, (size_t)WS_NEED); grid = -1; return; }
        int dev = 0, cus = 0, per_cu = 0;
        if (hipGetDevice(&dev) != hipSuccess || hipDeviceGetAttribute(&cus, hipDeviceAttributeMultiprocessorCount, dev) != hipSuccess) { grid = -1; return; }
        if (hipFuncSetAttribute((const void*)mega_fwd, hipFuncAttributeMaxDynamicSharedMemorySize, LDS_BYTES) != hipSuccess) { fprintf(stderr, "kernel_launch: hipFuncSetAttribute failed\n"); grid = -1; return; }
        if (hipOccupancyMaxActiveBlocksPerMultiprocessor(&per_cu, (const void*)mega_fwd, NWAVES * 64, LDS_BYTES) != hipSuccess || per_cu < 1) { fprintf(stderr, "kernel_launch: occupancy query says %d\n", per_cu); per_cu = 1; }
        (void)hipGetLastError();
        grid = cus;
    }
    if (grid < 0) return;
    (void)hipMemsetAsync((char*)d_ws, 0, CTL_BYTES, stream);
    Args a{};
    for (int i = 0; i < 30; ++i) a.in[i] = (const float*)d_in[i];
    a.out = (float*)d_out; a.ws = (unsigned char*)d_ws;
    void* kargs[] = {&a};
    hipError_t e = hipLaunchCooperativeKernel((const void*)mega_fwd, dim3(grid), dim3(NWAVES * 64), kargs, LDS_BYTES, stream);
    if (e != hipSuccess) { (void)hipGetLastError(); fprintf(stderr, "kernel_launch: cooperative launch failed (%s); plain launch\n", hipGetErrorString(e));
        hipLaunchKernelGGL(mega_fwd, dim3(grid), dim3(NWAVES * 64), LDS_BYTES, stream, a); }
}
```

```cpp
#include <hip/hip_runtime.h>
#include <cstdio>
#include <cstdint>
#ifndef PROBE_DUP
#define PROBE_DUP 0
#endif
#ifndef RET_ABL
#define RET_ABL 0
#endif
#ifndef ATT_ABL
#define ATT_ABL 0
#endif
#ifndef STG1
#define STG1 0
#endif
#ifndef STG2
#define STG2 0
#endif

#define LAS __attribute__((address_space(3)))
#define GAS __attribute__((address_space(1)))
typedef unsigned short bf16_t;
typedef short bf16x8 __attribute__((ext_vector_type(8)));
typedef short s16x4 __attribute__((ext_vector_type(4)));
typedef short v4i16_t __attribute__((ext_vector_type(4)));
typedef float f32x2 __attribute__((ext_vector_type(2)));
typedef float f32x4 __attribute__((ext_vector_type(4)));
typedef float f32x16 __attribute__((ext_vector_type(16)));
typedef unsigned u32x2 __attribute__((ext_vector_type(2)));
typedef unsigned u32x4 __attribute__((ext_vector_type(4)));
typedef __bf16 bf16x2_t __attribute__((ext_vector_type(2)));

constexpr int DM = 1024, NCTX = 8192, NLAT = 16384, MROWS = 24576, DFF = 2816;
constexpr float EPSV = 1e-6f;
constexpr float LOG2E = 1.4426950408889634f;

__device__ __forceinline__ unsigned cvtpk(float lo, float hi) { f32x2 v = {lo, hi}; bf16x2_t b = __builtin_convertvector(v, bf16x2_t); return __builtin_bit_cast(unsigned, b); }
__device__ __forceinline__ float bf2f(unsigned short x) { return __uint_as_float((unsigned)x << 16); }
__device__ __forceinline__ float bflo(unsigned w) { return __uint_as_float(w << 16); }
__device__ __forceinline__ float bfhi(unsigned w) { return __uint_as_float(w & 0xffff0000u); }
__device__ __forceinline__ float silu_f(float x) { return x * __builtin_amdgcn_rcpf(1.0f + __expf(-x)); }
__device__ __forceinline__ int crow(int r, int h) { return (r & 3) + 8 * (r >> 2) + 4 * h; }
#define PIN4(a, b, c, d) asm volatile("" : "+v"(a), "+v"(b), "+v"(c), "+v"(d))
#define PINV(x) asm volatile("" : "+v"(x))
#define FENCE() do { asm volatile("" ::: "memory"); __builtin_amdgcn_sched_barrier(0); } while (0)
#define MFMA32(a, b, c) __builtin_amdgcn_mfma_f32_32x32x16_bf16((a), (b), (c), 0, 0, 0)

namespace pg8 {
constexpr int BM = 256, BK = 64, HALF = 128, HTB = HALF * BK * 2, STAGE_BYTES = 8 * HTB, NXCD = 8, WGM = 8;
__host__ __device__ __forceinline__ int lds_byte(int r, int c) { const int st = (r >> 4) * 2 + (c >> 5), rr = r & 15, cc = c & 31, ob = rr * 64 + cc * 2; return st * 1024 + (ob ^ (((ob >> 9) & 1) << 5)); }
__host__ __device__ __forceinline__ void stage_rc(int b, int& R, int& C) { const int st = b / 1024, sb = b % 1024, swz = sb ^ (((sb >> 9) & 1) << 5); R = (st >> 1) * 16 + swz / 64; C = (st & 1) * 32 + (swz % 64) / 2; }
__host__ __device__ __forceinline__ int perm32(int rho) { const int n = rho >> 4, i = rho & 15; return 8 * (i >> 2) + 4 * n + (i & 3); }

struct Unit { int pm, pn, row0; };
struct Gemm { const bf16_t* A; const bf16_t* Bt; int K; };

__device__ __forceinline__ int ffn_row0(int pm) {
    if (pm < 32) return pm * 256;
    const int p = pm - 32, b = p / 9, k = p - 9 * b; const int s = 254 * k; return NCTX + b * 2048 + (s > 1792 ? 1792 : s);
}
struct TileOrder {
    int nM, nN, nwg, G, c, ffn, tm;
    __device__ __forceinline__ void init(int nM_, int nN_, int G_, int c_, int ffn_, int tm_ = 256) { nM = nM_; nN = nN_; nwg = nM * nN; G = G_; c = c_; ffn = ffn_; tm = tm_; }
    __device__ __forceinline__ bool next(int i, Unit& u) const {
        const long L = (long)i * G + c; if (L >= nwg) return false;
        int wgid = (int)L; { const int q = nwg / NXCD, r = nwg % NXCD, xcd = wgid % NXCD, off = wgid / NXCD; wgid = (xcd < r ? xcd * (q + 1) : r * (q + 1) + (xcd - r) * q) + off; }
        const int nig = WGM * nN, gid = wgid / nig, fm = gid * WGM, gsz = (nM - fm) < WGM ? (nM - fm) : WGM;
        u.pm = fm + ((wgid % nig) % gsz); u.pn = (wgid % nig) / gsz;
        u.row0 = ffn ? ffn_row0(u.pm) : u.pm * tm; return true;
    }
};


struct EpiRet {
    static constexpr bool PERM = true;
    bf16_t *q, *k, *v, *sgf, *sgb; const float* tab; int dry, nosilu;
    template <int MB>
    __device__ __forceinline__ void operator()(f32x4 (&acc)[2][2][MB][2], const Unit& u, int wr, int wc, int fr, int fq) const {
        const int pn = u.pn; const int rbase = u.row0 + wr * 64 + fr;
        if (pn < 8) {
            const bool isk = pn >= 4; bf16_t* dst = (isk ? k : q) + (pn & 3) * 256; const float sc = isk ? 0.0625f : 1.0f;
            const bool lat = u.row0 >= NCTX; const int i0 = 4 * (4 * wc + fq);
#define RET_TAB(k_, T_) do { const int r_ = rbase + ((k_) >> 2) * HALF + ((k_) & 3) * 16; const int s_ = (r_ - NCTX) & 2047; \
                const f32x4* ta_ = (const f32x4*)(tab + ((s_ >> 6) * 64 + i0) * 2); const f32x4* tb_ = (const f32x4*)(tab + ((s_ & 63) * 64 + i0) * 2); T_[0][0] = ta_[0]; T_[0][1] = ta_[1]; T_[1][0] = tb_[0]; T_[1][1] = tb_[1]; } while (0)
            f32x4 tc[2][2], tn[2][2];
            RET_TAB(0, tc);
#pragma unroll
            for (int kk = 0; kk < 8; ++kk) { const int ai = kk >> 2, m = kk & 3; const int r = rbase + ai * HALF + m * 16;
                    if (kk < 7) RET_TAB(kk + 1, tn);
                    f32x4 av[2][2] = {{acc[ai][0][m][0], acc[ai][0][m][1]}, {acc[ai][1][m][0], acc[ai][1][m][1]}}; PIN4(av[0][0], av[0][1], av[1][0], av[1][1]);
#pragma unroll
                    for (int bj = 0; bj < 2; ++bj) {
                        f32x4 x1 = av[bj][0] * sc, x2 = av[bj][1] * sc, o1 = x1, o2 = x2;
                        if (lat) { const f32x4 t0 = tc[bj][0], t1 = tc[bj][1];
                            const f32x4 cs = {t0[0], t0[2], t1[0], t1[2]}, sn = {t0[1], t0[3], t1[1], t1[3]};
                            o1 = x1 * cs - x2 * sn; o2 = x1 * sn + x2 * cs; }
                        bf16_t* p = dst + (size_t)r * 1024 + 128 * bj + i0;
                        u32x2 w1 = {cvtpk(o1[0], o1[1]), cvtpk(o1[2], o1[3])}, w2 = {cvtpk(o2[0], o2[1]), cvtpk(o2[2], o2[3])};
                        if (!dry) { *(u32x2*)p = w1; *(u32x2*)(p + 64) = w2; } else asm volatile("" :: "v"(w1), "v"(w2)); }
                    asm volatile("" ::: "memory");
#pragma unroll
                    for (int bj = 0; bj < 2; ++bj) { tc[bj][0] = tn[bj][0]; tc[bj][1] = tn[bj][1]; } }
#undef RET_TAB
        } else if (pn < 16) { store_plain(acc, v, (pn - 8) * 256, false, rbase, wc, fq); }
        else if (pn < 24) { store_plain(acc, sgf, (pn - 16) * 256, true, rbase, wc, fq); }
        else { store_plain(acc, sgb, (pn - 24) * 256, true, rbase, wc, fq); }
    }
    __device__ __forceinline__ void store_plain(const f32x4 (&acc)[2][2][4][2], bf16_t* dst, int col0, bool act, int rbase, int wc, int fq) const {
        const int col = col0 + wc * 32 + 8 * fq;
#pragma unroll
        for (int ai = 0; ai < 2; ++ai)
#pragma unroll
            for (int m = 0; m < 4; ++m) { bf16_t* rowp = dst + (size_t)(rbase + ai * HALF + m * 16) * 2048 + col;
                f32x4 av[2][2] = {{acc[ai][0][m][0], acc[ai][0][m][1]}, {acc[ai][1][m][0], acc[ai][1][m][1]}}; PIN4(av[0][0], av[0][1], av[1][0], av[1][1]);
#pragma unroll
                for (int bj = 0; bj < 2; ++bj) { f32x4 v0 = av[bj][0], v1 = av[bj][1];
                    if (act && !nosilu) { for (int j = 0; j < 4; ++j) { v0[j] = silu_f(v0[j]); v1[j] = silu_f(v1[j]); } }
                    u32x4 w; w.x = cvtpk(v0[0], v0[1]); w.y = cvtpk(v0[2], v0[3]); w.z = cvtpk(v1[0], v1[1]); w.w = cvtpk(v1[2], v1[3]);
                    if (!dry) *(u32x4*)(rowp + bj * HALF) = w; else asm volatile("" :: "v"(w)); }
                asm volatile("" ::: "memory"); }
    }
};

struct EpiNull { static constexpr bool PERM = true; float* sink;
    template <int MB> __device__ __forceinline__ void operator()(f32x4 (&acc)[2][2][MB][2], const Unit& u, int wr, int wc, int fr, int fq) const {
        f32x4 t = acc[0][0][0][0];
#pragma unroll
        for (int a = 0; a < 2; ++a)
#pragma unroll
            for (int b = 0; b < 2; ++b)
#pragma unroll
                for (int m = 0; m < MB; ++m) { t += acc[a][b][m][0]; t += acc[a][b][m][1]; }
        if (t[0] == 12345.678f) sink[0] = t[1] + t[2] + t[3]; } };

template <bool INF32>
struct EpiResidT {
    static constexpr bool PERM = true;
    const float* xa; const float* xb; const bf16_t* xs; bf16_t* xo; const float* gate;
    bf16_t* xt; const float* gn; const float* scn; float* nst; int dry;
    template <int MB>
    __device__ __forceinline__ void operator()(f32x4 (&acc)[2][2][MB][2], const Unit& u, int wr, int wc, int fr, int fq) const {
        const int col0 = u.pn * BM + wc * 32 + 8 * fq;
        const int mb0 = u.row0 < NCTX ? 8 : ((u.row0 - NCTX) >> 11);
        f32x4 gv0[2][2], av0[2][2];
#pragma unroll
        for (int bj = 0; bj < 2; ++bj)
#pragma unroll
            for (int n = 0; n < 2; ++n) { const int c = col0 + bj * HALF + n * 4; gv0[bj][n] = *(const f32x4*)(gate + mb0 * 6144 + c);
                av0[bj][n] = xt ? *(const f32x4*)(gn + c) * (1.0f + *(const f32x4*)(scn + mb0 * 6144 + c)) : (f32x4){0.f, 0.f, 0.f, 0.f}; }
        const int rb = u.row0 + wr * 16 * MB + fr;
        f32x4 xc[2][2], xn2[2][2];
#define RES_LOAD(k_, X_) do { const int r_ = rb + ((k_) / MB) * 32 * MB + ((k_) % MB) * 16; \
            if (INF32) { const float* p_ = (r_ < NCTX ? xa + (size_t)r_ * 1024 : xb + (size_t)(r_ - NCTX) * 1024) + col0; \
                _Pragma("unroll") for (int bj = 0; bj < 2; ++bj) { X_[bj][0] = *(const f32x4*)(p_ + bj * HALF); X_[bj][1] = *(const f32x4*)(p_ + bj * HALF + 4); } } \
            else { const bf16_t* p_ = xs + (size_t)r_ * 1024 + col0; \
                _Pragma("unroll") for (int bj = 0; bj < 2; ++bj) { const u32x4 w_ = *(const u32x4*)(p_ + bj * HALF); X_[bj][0] = (f32x4){bflo(w_.x), bfhi(w_.x), bflo(w_.y), bfhi(w_.y)}; X_[bj][1] = (f32x4){bflo(w_.z), bfhi(w_.z), bflo(w_.w), bfhi(w_.w)}; } } } while (0)
        RES_LOAD(0, xc);
#pragma unroll
        for (int k = 0; k < 2 * MB; ++k) { const int ai = k / MB, m = k % MB; const int r = rb + ai * 32 * MB + m * 16;
            if (k + 1 < 2 * MB) RES_LOAD(k + 1, xn2);
            const int mb = r < NCTX ? 8 : ((r - NCTX) >> 11);
            f32x4 av[2][2] = {{acc[ai][0][m][0], acc[ai][0][m][1]}, {acc[ai][1][m][0], acc[ai][1][m][1]}}; PIN4(av[0][0], av[0][1], av[1][0], av[1][1]);
            float ss = 0.f;
#pragma unroll
            for (int bj = 0; bj < 2; ++bj) { f32x4 xv[2], yv[2];
#pragma unroll
                for (int n = 0; n < 2; ++n) { const int c = col0 + bj * HALF + n * 4; f32x4 gv = gv0[bj][n], a4 = av0[bj][n];
                    if (mb != mb0) { gv = *(const f32x4*)(gate + mb * 6144 + c); if (xt) a4 = *(const f32x4*)(gn + c) * (1.0f + *(const f32x4*)(scn + mb * 6144 + c)); }
                    xv[n] = xc[bj][n] + gv * av[bj][n]; yv[n] = xv[n] * a4;
                    ss += (xv[n][0] * xv[n][0] + xv[n][1] * xv[n][1]) + (xv[n][2] * xv[n][2] + xv[n][3] * xv[n][3]); }
                u32x4 wx; wx.x = cvtpk(xv[0][0], xv[0][1]); wx.y = cvtpk(xv[0][2], xv[0][3]); wx.z = cvtpk(xv[1][0], xv[1][1]); wx.w = cvtpk(xv[1][2], xv[1][3]);
                if (!dry) *(u32x4*)(xo + (size_t)r * 1024 + col0 + bj * HALF) = wx; else asm volatile("" :: "v"(wx));
                if (xt) { u32x4 wy; wy.x = cvtpk(yv[0][0], yv[0][1]); wy.y = cvtpk(yv[0][2], yv[0][3]); wy.z = cvtpk(yv[1][0], yv[1][1]); wy.w = cvtpk(yv[1][2], yv[1][3]);
                    if (!dry) *(u32x4*)(xt + (size_t)r * 1024 + col0 + bj * HALF) = wy; else asm volatile("" :: "v"(wy)); } }
            if (xt) { ss += __shfl_xor(ss, 16); ss += __shfl_xor(ss, 32); if (fq == 0 && !dry) atomicAdd(nst + r, ss); else asm volatile("" :: "v"(ss)); }
            asm volatile("" ::: "memory");
#pragma unroll
            for (int bj = 0; bj < 2; ++bj)
#pragma unroll
                for (int n = 0; n < 2; ++n) xc[bj][n] = xn2[bj][n];
        }
#undef RES_LOAD
    }
};

struct EpiAttnQKV {
    static constexpr bool PERM = true;
    bf16_t *q, *k, *v; float *ok, *ov; const float* tab;
    const float* nst; const float* cb;
    template <int MB>
    __device__ __forceinline__ void operator()(f32x4 (&acc)[2][2][MB][2], const Unit& u, int wr, int wc, int fr, int fq) const {
        const int pn = u.pn; const int rbase = u.row0 + wr * 16 * MB + fr;
        float rsn[2 * MB];
#pragma unroll
        for (int k = 0; k < 2 * MB; ++k) rsn[k] = nst[rbase + (k / MB) * 32 * MB + (k % MB) * 16];
        if (pn < 5) {
            const bool isk = pn == 4; const float sc = isk ? 1.0f : 0.125f * LOG2E; const int half = wc & 1, i0 = 4 * fq;
            const int mb0 = u.row0 < NCTX ? 8 : ((u.row0 - NCTX) >> 11);
            const int cboff = (isk ? 1024 : pn * 256) + (wc >> 1) * 64 + 32 * half + i0;
            f32x4 cb0[2][2];
#pragma unroll
            for (int bj = 0; bj < 2; ++bj) { cb0[bj][0] = *(const f32x4*)(cb + mb0 * 1536 + cboff + 128 * bj); cb0[bj][1] = *(const f32x4*)(cb + mb0 * 1536 + cboff + 128 * bj + 16); }
#define QKV_TAB(k_, T0_, T1_) do { const int r_ = rbase + ((k_) / MB) * 32 * MB + ((k_) % MB) * 16; const int s_ = (r_ - NCTX) & 2047; const int pos_ = half ? (s_ & 63) : (s_ >> 6); \
                const f32x4* tp_ = (const f32x4*)(tab + (pos_ * 16 + i0) * 2); T0_ = tp_[0]; T1_ = tp_[1]; } while (0)
            f32x4 tc0, tc1, tn0, tn1;
            QKV_TAB(0, tc0, tc1);
#pragma unroll
            for (int kk = 0; kk < 2 * MB; ++kk) { const int ai = kk / MB, m = kk % MB; const int r = rbase + ai * 32 * MB + m * 16; const bool lat = r >= NCTX;
                    if (kk + 1 < 2 * MB) QKV_TAB(kk + 1, tn0, tn1);
                    f32x4 av[2][2] = {{acc[ai][0][m][0], acc[ai][0][m][1]}, {acc[ai][1][m][0], acc[ai][1][m][1]}}; PIN4(av[0][0], av[0][1], av[1][0], av[1][1]);
                    { const float rstd = 1.0f / sqrtf(rsn[ai * MB + m] * (1.0f / 1024.0f) + EPSV); const int mb = r < NCTX ? 8 : ((r - NCTX) >> 11);
#pragma unroll
                      for (int bj = 0; bj < 2; ++bj) { f32x4 c0 = cb0[bj][0], c1 = cb0[bj][1];
                          if (mb != mb0) { c0 = *(const f32x4*)(cb + mb * 1536 + cboff + 128 * bj); c1 = *(const f32x4*)(cb + mb * 1536 + cboff + 128 * bj + 16); }
                          av[bj][0] = av[bj][0] * rstd + c0; av[bj][1] = av[bj][1] * rstd + c1; } }
                    f32x4 cs = {1.f, 1.f, 1.f, 1.f}, sn = {0.f, 0.f, 0.f, 0.f};
                    if (lat) { cs = (f32x4){tc0[0], tc0[2], tc1[0], tc1[2]}; sn = (f32x4){tc0[1], tc0[3], tc1[1], tc1[3]}; }
#pragma unroll
                    for (int bj = 0; bj < 2; ++bj) { const int hh = 2 * bj + (wc >> 1);
                        const f32x4 x1 = av[bj][0], x2 = av[bj][1];
                        const f32x4 o1 = (x1 * cs - x2 * sn) * sc, o2 = (x1 * sn + x2 * cs) * sc;
                        const int t1c = 32 * half + i0;
                        bf16_t* p = isk ? k + (size_t)r * 256 + hh * 64 + t1c : q + (size_t)r * 1024 + (pn * 4 + hh) * 64 + t1c;
                        u32x2 w1 = {cvtpk(o1[0], o1[1]), cvtpk(o1[2], o1[3])}, w2 = {cvtpk(o2[0], o2[1]), cvtpk(o2[2], o2[3])};
                        *(u32x2*)p = w1; *(u32x2*)(p + 16) = w2;
                        if (isk && !lat) { float* o = ok + (size_t)r * 256 + hh * 64 + t1c; *(f32x4*)o = x1; *(f32x4*)(o + 16) = x2; } }
                    asm volatile("" ::: "memory"); tc0 = tn0; tc1 = tn1; }
#undef QKV_TAB
        } else {
            const int col = wc * 32 + 8 * fq;
#pragma unroll
            for (int ai = 0; ai < 2; ++ai)
#pragma unroll
                for (int m = 0; m < MB; ++m) { const int r = rbase + ai * 32 * MB + m * 16; const bool lat = r >= NCTX;
                    f32x4 av[2][2] = {{acc[ai][0][m][0], acc[ai][0][m][1]}, {acc[ai][1][m][0], acc[ai][1][m][1]}}; PIN4(av[0][0], av[0][1], av[1][0], av[1][1]);
                    { const float rstd = 1.0f / sqrtf(rsn[ai * MB + m] * (1.0f / 1024.0f) + EPSV); const int mb = r < NCTX ? 8 : ((r - NCTX) >> 11);
#pragma unroll
                      for (int bj = 0; bj < 2; ++bj) { const float* cp = cb + mb * 1536 + 1280 + col + bj * HALF;
                          av[bj][0] = av[bj][0] * rstd + *(const f32x4*)cp; av[bj][1] = av[bj][1] * rstd + *(const f32x4*)(cp + 4); } }
#pragma unroll
                    for (int bj = 0; bj < 2; ++bj) { const f32x4 v0 = av[bj][0], v1 = av[bj][1];
                        u32x4 w; w.x = cvtpk(v0[0], v0[1]); w.y = cvtpk(v0[2], v0[3]); w.z = cvtpk(v1[0], v1[1]); w.w = cvtpk(v1[2], v1[3]);
                        *(u32x4*)(v + (size_t)r * 256 + col + bj * HALF) = w;
                        if (!lat) { float* o = ov + (size_t)r * 256 + col + bj * HALF; *(f32x4*)o = v0; *(f32x4*)(o + 4) = v1; } }
                    asm volatile("" ::: "memory"); }
        }
    }
};

struct EpiFfn {
    static constexpr bool PERM = true;
    bf16_t* act; const float* cw; const float* cb; LAS float* xch;
    const float* nst; const float* cbias; int dry;
    template <int MB>
    __device__ __forceinline__ void operator()(f32x4 (&acc)[2][2][MB][2], const Unit& u, int wr, int wc, int fr, int fq) const {
        const int lane = 16 * fq + fr; (void)lane;
        f32x4 cwv[2][8];
#define FFN_LDW(bj_) do { const int c0_ = u.pn * 128 + 64 * (bj_) + 16 * wc + 4 * fq; \
            cwv[bj_][0] = *(const f32x4*)(cw + c0_); cwv[bj_][1] = *(const f32x4*)(cw + 5632 + c0_); cwv[bj_][2] = *(const f32x4*)(cw + 2 * 5632 + c0_); cwv[bj_][3] = *(const f32x4*)(cb + c0_); \
            cwv[bj_][4] = *(const f32x4*)(cw + DFF + c0_); cwv[bj_][5] = *(const f32x4*)(cw + 5632 + DFF + c0_); cwv[bj_][6] = *(const f32x4*)(cw + 2 * 5632 + DFF + c0_); cwv[bj_][7] = *(const f32x4*)(cb + DFF + c0_); } while (0)
        FFN_LDW(0);
        { const int mb = u.row0 < NCTX ? 8 : ((u.row0 - NCTX) >> 11);
          f32x4 cu[2], cg[2];
#pragma unroll
          for (int bj = 0; bj < 2; ++bj) { const int c0 = u.pn * 128 + 64 * bj + 16 * wc + 4 * fq; cu[bj] = *(const f32x4*)(cbias + mb * 5632 + c0); cg[bj] = *(const f32x4*)(cbias + mb * 5632 + DFF + c0); }
          float rs8[8];
#pragma unroll
          for (int k = 0; k < 8; ++k) rs8[k] = nst[u.row0 + (k >> 2) * HALF + wr * 64 + (k & 3) * 16 + fr];
#pragma unroll
          for (int ai = 0; ai < 2; ++ai)
#pragma unroll
              for (int m = 0; m < 4; ++m) { float rstd = 1.0f / sqrtf(rs8[ai * 4 + m] * (1.0f / 1024.0f) + EPSV);
                  PIN4(acc[ai][0][m][0], acc[ai][0][m][1], acc[ai][1][m][0], acc[ai][1][m][1]);
#pragma unroll
                  for (int bj = 0; bj < 2; ++bj) { acc[ai][bj][m][0] = acc[ai][bj][m][0] * rstd + cu[bj]; acc[ai][bj][m][1] = acc[ai][bj][m][1] * rstd + cg[bj]; }
                  PIN4(acc[ai][0][m][0], acc[ai][0][m][1], acc[ai][1][m][0], acc[ai][1][m][1]); asm volatile("" ::: "memory"); } }
        int lo = 0, hi = 256;
        if (u.pm >= 32) { const int k = (u.pm - 32) % 9; if (k == 0) { hi = 255; } else if (k < 8) { lo = 1; hi = 255; } else { lo = 241; hi = 256; } }
#pragma unroll
        for (int ai = 0; ai < 2; ++ai)
#pragma unroll
            for (int bj = 0; bj < 2; ++bj) {
                if (fr == 0) { LAS f32x4* p = (LAS f32x4*)xch + ((((ai * 2 + wr) * 2 + 0) * 4 + wc) * 4 + fq) * 4 + bj * 2; p[0] = acc[ai][bj][0][0]; p[1] = acc[ai][bj][0][1]; }
                if (fr == 15) { LAS f32x4* p = (LAS f32x4*)xch + ((((ai * 2 + wr) * 2 + 1) * 4 + wc) * 4 + fq) * 4 + bj * 2; p[0] = acc[ai][bj][3][0]; p[1] = acc[ai][bj][3][1]; }
            }
        asm volatile("s_waitcnt lgkmcnt(0)" ::: "memory"); __builtin_amdgcn_s_barrier(); asm volatile("" ::: "memory");
        FFN_LDW(1);
#pragma unroll
        for (int bj = 0; bj < 2; ++bj) {
            const int c0 = u.pn * 128 + 64 * bj + 16 * wc + 4 * fq;
            const f32x4 wu0 = cwv[bj][0], wu1 = cwv[bj][1], wu2 = cwv[bj][2], bu = cwv[bj][3], wg0 = cwv[bj][4], wg1 = cwv[bj][5], wg2 = cwv[bj][6], bg = cwv[bj][7];
#pragma unroll
            for (int ai = 0; ai < 2; ++ai) {
#pragma unroll
                for (int m = 0; m < 4; ++m) {
                    f32x4 uc = acc[ai][bj][m][0], gc = acc[ai][bj][m][1];
                    f32x4 sp_u = (m > 0 && fr == 15) ? acc[ai][bj][m > 0 ? m - 1 : 0][0] : uc, sp_g = (m > 0 && fr == 15) ? acc[ai][bj][m > 0 ? m - 1 : 0][1] : gc;
                    f32x4 sn_u = (m < 3 && fr == 0) ? acc[ai][bj][m < 3 ? m + 1 : 3][0] : uc, sn_g = (m < 3 && fr == 0) ? acc[ai][bj][m < 3 ? m + 1 : 3][1] : gc;
                    PIN4(uc, gc, sp_u, sp_g); PIN4(sn_u, sn_g, uc, gc);
                    f32x4 up, gp, un, gn;
#pragma unroll
                    for (int j = 0; j < 4; ++j) {
                        up[j] = __int_as_float(__builtin_amdgcn_update_dpp(0, __float_as_int(sp_u[j]), 0x121, 0xf, 0xf, false)); gp[j] = __int_as_float(__builtin_amdgcn_update_dpp(0, __float_as_int(sp_g[j]), 0x121, 0xf, 0xf, false));
                        un[j] = __int_as_float(__builtin_amdgcn_update_dpp(0, __float_as_int(sn_u[j]), 0x12F, 0xf, 0xf, false)); gn[j] = __int_as_float(__builtin_amdgcn_update_dpp(0, __float_as_int(sn_g[j]), 0x12F, 0xf, 0xf, false)); }
                    if (m == 0) {
                        f32x4 pu = {0.f, 0.f, 0.f, 0.f}, pg = pu; int pai = ai, pwr = wr - 1; if (pwr < 0) { pwr = 1; pai = ai - 1; }
                        if (pai >= 0) { const LAS f32x4* p = (const LAS f32x4*)xch + ((((pai * 2 + pwr) * 2 + 1) * 4 + wc) * 4 + fq) * 4 + bj * 2; pu = p[0]; pg = p[1]; }
                        if (fr == 0) { up = pu; gp = pg; } }
                    if (m == 3) {
                        f32x4 nu = {0.f, 0.f, 0.f, 0.f}, ng = nu; int nai = ai, nwr = wr + 1; if (nwr > 1) { nwr = 0; nai = ai + 1; }
                        if (nai < 2) { const LAS f32x4* p = (const LAS f32x4*)xch + ((((nai * 2 + nwr) * 2 + 0) * 4 + wc) * 4 + fq) * 4 + bj * 2; nu = p[0]; ng = p[1]; }
                        if (fr == 15) { un = nu; gn = ng; } }
                    const f32x4 uu = wu0 * up + wu1 * uc + wu2 * un + bu;
                    const f32x4 gg = wg0 * gp + wg1 * gc + wg2 * gn + bg;
                    const int lr = ai * HALF + wr * 64 + m * 16 + fr;
                    if (lr >= lo && lr < hi) { u32x2 w = {cvtpk(silu_f(gg[0]) * uu[0], silu_f(gg[1]) * uu[1]), cvtpk(silu_f(gg[2]) * uu[2], silu_f(gg[3]) * uu[3])};
                        if (!dry) *(u32x2*)(act + (size_t)(u.row0 + lr) * DFF + c0) = w; else asm volatile("" :: "v"(w)); }
                    asm volatile("" ::: "memory");
                }
            }
        }
        asm volatile("s_waitcnt lgkmcnt(0)" ::: "memory"); __builtin_amdgcn_s_barrier(); asm volatile("" ::: "memory");
#undef FFN_LDW
    }
};

template <int MB, class Epi, class Sched>
__device__ __forceinline__ void gemm_phase(LAS unsigned char* lds, const Gemm g, const Sched& S, const Epi& E, int stagger = 0) {
    if (stagger) { const unsigned long long t0 = __builtin_amdgcn_s_memrealtime(); const unsigned long long dl = (unsigned long long)((S.c >> 3) & 7) * (unsigned)stagger; while (__builtin_amdgcn_s_memrealtime() - t0 < dl) __builtin_amdgcn_s_sleep(4); }
    int tid_ = threadIdx.x; asm volatile("" : "+v"(tid_));
    const int tid = tid_, wid = __builtin_amdgcn_readfirstlane(tid >> 6), lane = tid & 63, wr = wid >> 2, wc = wid & 3, fr = lane & 15, fq = lane >> 4;
    const int K = g.K, nt = K / BK;
    unsigned voffA[2], voffB[2];
#pragma unroll
    for (int i = 0; i < 2; ++i) { int R, C; stage_rc(tid * 16 + i * 8192, R, C); const int Rb = Epi::PERM ? ((R & ~31) + perm32(R & 31)) : R;
        voffA[i] = (unsigned)(R * K + C) * 2u; voffB[i] = (unsigned)(Rb * K + C) * 2u; }
    const size_t kstep = (size_t)(BK * 2);
    const size_t hstep = (size_t)HALF * K * 2;
    const size_t hstepA = (size_t)(32 * MB) * K * 2;
    const size_t tstep = 2 * hstep;
    const size_t rstep = (size_t)K * 2;
    const unsigned ldsw = (unsigned)wid * 1024u;
    const int aoff = lds_byte(wr * 16 * MB + fr, fq * 8), boff = lds_byte(wc * 32 + fr, fq * 8);
#define PG8_SA(b, h) (((b) * 2 + (h)) * HTB)
#define PG8_SB(b, h) ((4 + (b) * 2 + (h)) * HTB)
#define PG8_STAGE(bufoff, gbase, voff) do { _Pragma("unroll") for (int _i = 0; _i < 2; ++_i) \
        __builtin_amdgcn_global_load_lds((const unsigned*)((const char*)(gbase) + (voff)[_i]), (LAS unsigned*)(lds + (bufoff) + ldsw + _i * 8192), 16, 0, 0); } while (0)
#define PG8_LDA(dst, b, h) do { _Pragma("unroll") for (int m = 0; m < MB; ++m) _Pragma("unroll") for (int k = 0; k < 2; ++k) dst[m][k] = *(const LAS bf16x8*)(lds + PG8_SA(b, h) + aoff + m * 2048 + k * 1024); } while (0)
#define PG8_LDB(dst, b, h) do { _Pragma("unroll") for (int n = 0; n < 2; ++n) _Pragma("unroll") for (int k = 0; k < 2; ++k) dst[n][k] = *(const LAS bf16x8*)(lds + PG8_SB(b, h) + boff + n * 2048 + k * 1024); } while (0)
#define PG8_MMA(ai, bj, At, Bt) do { __builtin_amdgcn_s_setprio(1); _Pragma("unroll") for (int m = 0; m < MB; ++m) _Pragma("unroll") for (int n = 0; n < 2; ++n) _Pragma("unroll") for (int k = 0; k < 2; ++k) \
        acc[ai][bj][m][n] = __builtin_amdgcn_mfma_f32_16x16x32_bf16(Bt[n][k], At[m][k], acc[ai][bj][m][n], 0, 0, 0); __builtin_amdgcn_s_setprio(0); } while (0)
#define PG8_WAIT_V(n) asm volatile("s_waitcnt vmcnt(" #n ")" ::: "memory")
#define PG8_WAIT_L(n) asm volatile("s_waitcnt lgkmcnt(" #n ")" ::: "memory")
#define PG8_BAR __builtin_amdgcn_s_barrier()
#define PG8_SCHED __builtin_amdgcn_sched_barrier(0)
    Unit cur, nxt; int ui = 0;
    if (!S.next(0, cur)) return;
    f32x4 acc[2][2][MB][2];
#pragma unroll
    for (int a = 0; a < 2; ++a)
#pragma unroll
        for (int b = 0; b < 2; ++b)
#pragma unroll
            for (int m = 0; m < MB; ++m)
#pragma unroll
                for (int n = 0; n < 2; ++n) acc[a][b][m][n] = (f32x4){0.f, 0.f, 0.f, 0.f};
    bf16x8 At[MB][2], B0[2][2], B1[2][2];
    const char* cA = (const char*)g.A + (size_t)cur.row0 * rstep; const char* cB = (const char*)g.Bt + (size_t)cur.pn * tstep;
    PG8_STAGE(PG8_SB(0, 0), cB, voffB); PG8_STAGE(PG8_SB(0, 1), cB + hstep, voffB); PG8_STAGE(PG8_SA(0, 0), cA, voffA); PG8_STAGE(PG8_SA(0, 1), cA + hstepA, voffA);
    if (wr == 1) PG8_BAR;
    PG8_WAIT_V(2); PG8_BAR;
    PG8_STAGE(PG8_SB(1, 0), cB + kstep, voffB); PG8_STAGE(PG8_SA(1, 0), cA + kstep, voffA); PG8_STAGE(PG8_SB(1, 1), cB + hstep + kstep, voffB);
    PG8_WAIT_V(6); PG8_BAR;
    for (;;) {
        const bool has_next = S.next(ui + 1, nxt);
        const char* nA = has_next ? (const char*)g.A + (size_t)nxt.row0 * rstep : cA; const char* nB = has_next ? (const char*)g.Bt + (size_t)nxt.pn * tstep : cB;
        for (int t = 0; t < nt; t += 2) {
            const bool last = (t == nt - 2);
            const char* a1 = cA + (size_t)(t + 1) * kstep;
            const char* a2 = last ? nA : cA + (size_t)(t + 2) * kstep; const char* b2 = last ? nB : cB + (size_t)(t + 2) * kstep;
            const char* a3 = a2 + kstep; const char* b3 = b2 + kstep;
            PG8_LDB(B0, 0, 0); PG8_LDB(B1, 0, 1); PG8_SCHED; PG8_LDA(At, 0, 0); PG8_STAGE(PG8_SA(1, 1), a1 + hstepA, voffA);
            PG8_WAIT_V(8); PG8_WAIT_L(0); PG8_BAR; PG8_MMA(0, 0, At, B0); PG8_MMA(0, 1, At, B1); PG8_BAR; PG8_SCHED;
            PG8_LDA(At, 0, 1); PG8_STAGE(PG8_SB(0, 0), b2, voffB); PG8_STAGE(PG8_SB(0, 1), b2 + hstep, voffB); PG8_STAGE(PG8_SA(0, 0), a2, voffA);
            PG8_WAIT_V(8); PG8_WAIT_L(0); PG8_BAR; PG8_MMA(1, 0, At, B0); PG8_MMA(1, 1, At, B1); PG8_BAR; PG8_SCHED;
            PG8_LDB(B0, 1, 0); PG8_LDB(B1, 1, 1); PG8_SCHED; PG8_LDA(At, 1, 0); PG8_STAGE(PG8_SA(0, 1), a2 + hstepA, voffA);
            PG8_WAIT_V(8); PG8_WAIT_L(0); PG8_BAR; PG8_MMA(0, 0, At, B0); PG8_MMA(0, 1, At, B1); PG8_BAR; PG8_SCHED;
            PG8_LDA(At, 1, 1); PG8_STAGE(PG8_SB(1, 0), b3, voffB); PG8_STAGE(PG8_SB(1, 1), b3 + hstep, voffB); PG8_STAGE(PG8_SA(1, 0), a3, voffA);
            PG8_WAIT_V(8); PG8_WAIT_L(0); PG8_BAR; PG8_MMA(1, 0, At, B0); PG8_MMA(1, 1, At, B1); PG8_BAR; PG8_SCHED;
        }
        if (wr == 0) PG8_BAR;
        { int l2 = threadIdx.x & 63; asm volatile("" : "+v"(l2)); E.template operator()<MB>(acc, cur, wr, wc, l2 & 15, l2 >> 4); }
        if (!has_next) break;
#pragma unroll
        for (int a = 0; a < 2; ++a)
#pragma unroll
            for (int b = 0; b < 2; ++b)
#pragma unroll
                for (int m = 0; m < MB; ++m)
#pragma unroll
                    for (int n = 0; n < 2; ++n) acc[a][b][m][n] = (f32x4){0.f, 0.f, 0.f, 0.f};
        cur = nxt; cA = nA; cB = nB; ++ui;
        if (wr == 1) PG8_BAR;
    }
    PG8_WAIT_V(0);
    PG8_BAR;
#undef PG8_SA
#undef PG8_SB
#undef PG8_STAGE
#undef PG8_LDA
#undef PG8_LDB
#undef PG8_MMA
#undef PG8_WAIT_V
#undef PG8_WAIT_L
#undef PG8_BAR
#undef PG8_SCHED
}
}

constexpr int NWAVES = 8;
constexpr size_t MiB = 1u << 20;
constexpr size_t CTL_BYTES = 2 * MiB;
constexpr size_t CTL_BAR_B = 16384, CTL_MOD_B = 65536, CTL_STATS_B = 524288;
constexpr size_t WS_TABR = 2 * MiB, WS_TABA = 2 * MiB + 65536;
constexpr size_t WS_CK = 3 * MiB, WS_CV = 4 * MiB;
constexpr size_t WS_Q = 8 * MiB, WS_K = 56 * MiB, WS_V = 104 * MiB, WS_SGF = 200 * MiB, WS_NEED = 296 * MiB;
constexpr size_t WS_Y = 200 * MiB;
constexpr size_t WS_NST = 5 * MiB;
constexpr size_t WS_CB = 5 * MiB + 512 * 1024;
constexpr int CB_FFN0 = 0, CB_FFN1 = 9 * 5632, CB_QKV = 2 * 9 * 5632, CB_TOTAL = 2 * 9 * 5632 + 9 * 1536;
constexpr size_t WS_WO_RET = 104 * MiB, WS_WIN0 = 108 * MiB, WS_WIN1 = 119 * MiB, WS_WOUT0 = 130 * MiB, WS_WOUT1 = 135 * MiB + 512 * 1024,
                 WS_WQKV = 141 * MiB, WS_WOA = 144 * MiB;
constexpr size_t WS_H = 8 * MiB;
constexpr size_t WS_ACT = 160 * MiB;
constexpr size_t WS_AQ = 56 * MiB, WS_AK = 146 * MiB, WS_AV = 158 * MiB, WS_AO = 200 * MiB;
constexpr size_t OUT_SGB = 0;
constexpr size_t OUT_H0 = 96 * MiB, OUT_W1T = 144 * MiB;
constexpr size_t OUT_SF = (size_t)25165824 * 4, OUT_SB = (size_t)41943040 * 4, OUT_NK = (size_t)58720256 * 4, OUT_NV = (size_t)60817408 * 4;
constexpr int RING_BYTES = 131072, XCH_OFF = 131072, LDSCTL_OFF = 147456, MISC_OFF = LDSCTL_OFF + 320, INTAB_OFF = LDSCTL_OFF + 512, LDS_BYTES = 151552;

typedef GAS unsigned gu32;
#define RLX_AGENT __ATOMIC_RELAXED, __HIP_MEMORY_SCOPE_AGENT
#define PHASE_IDS() int tid_ = threadIdx.x; asm volatile("" : "+v"(tid_)); const int tid = tid_, lane = tid & 63, wid = __builtin_amdgcn_readfirstlane(tid >> 6); (void)tid; (void)lane; (void)wid; (void)0

#define XB_TMO      128
#define XB_XCNT(j)  (256  + 64 * (j))
#define XB_XSUB(j)  (1280 + 64 * (j))
#define XB_XGEN(j)  (2304 + 64 * (j))
#define XB_TOP      3328
#define XB_TOPGEN   3392
#define XCD_BAR_WORDS 3456
#define XB_SPIN_CAP (1u << 27)
__device__ __forceinline__ unsigned xb_ld(unsigned* p)              { return __hip_atomic_load(p, __ATOMIC_RELAXED, __HIP_MEMORY_SCOPE_AGENT); }
__device__ __forceinline__ unsigned xb_add(unsigned* p, unsigned v) { return __hip_atomic_fetch_add(p, v, __ATOMIC_RELAXED, __HIP_MEMORY_SCOPE_AGENT); }
__device__ __forceinline__ unsigned xb_xcc_id() { return (unsigned)__builtin_amdgcn_s_getreg((3 << 11) | 20) & 0xFu; }
#define XB_SPIN(cond, bar) do { unsigned _sp = 0; while (cond) { __builtin_amdgcn_s_sleep(1); \
    if ((++_sp & 255u) == 0u) { if (xb_ld(&(bar)[XB_TMO])) break; if (_sp > XB_SPIN_CAP) { atomicAdd(&(bar)[XB_TMO], 1u); break; } } } } while (0)
struct XcdBarrier { unsigned* bar; unsigned x; volatile LAS unsigned* st; };
__device__ __forceinline__ XcdBarrier xcd_barrier_post(unsigned* bar, volatile LAS unsigned* st) {
    XcdBarrier b; b.bar = bar; b.x = (unsigned)__builtin_amdgcn_readfirstlane((int)xb_xcc_id()); b.st = st;
    if (threadIdx.x == 0) (void)xb_add(&bar[XB_XCNT(b.x)], 1u);
    return b;
}
__device__ __forceinline__ void xcd_barrier_complete(unsigned* bar, unsigned x, unsigned& nloc, unsigned& nx) {
    const unsigned G = gridDim.x * gridDim.y * gridDim.z;
    unsigned sum, cnt, mine, sp = 0u;
    for (;;) {
        sum = 0u; cnt = 0u; mine = 0u;
#pragma unroll
        for (unsigned j = 0; j < 16; ++j) { const unsigned c = xb_ld(&bar[XB_XCNT(j)]); sum += c; cnt += (c > 0u) ? 1u : 0u; }
        if (sum == G) { mine = xb_ld(&bar[XB_XCNT(x)]); break; }
        __builtin_amdgcn_s_sleep(1);
        if ((++sp & 255u) == 0u) { if (xb_ld(&bar[XB_TMO])) break; if (sp > XB_SPIN_CAP) { atomicAdd(&bar[XB_TMO], 1u); break; } }
    }
    nloc = mine > 0u ? mine : 1u; nx = cnt > 0u ? cnt : 1u;
}
__device__ __forceinline__ void xcd_barrier(const XcdBarrier& b) {
    asm volatile("s_waitcnt vmcnt(0)" ::: "memory");
    __syncthreads();
    if (threadIdx.x == 0) {
        unsigned* bar = b.bar; unsigned bxx = b.x; asm volatile("" : "+s"(bar), "+s"(bxx));
        __builtin_amdgcn_s_waitcnt(0);
        unsigned nloc = b.st[0], nx = b.st[1];
        if (nloc == 0u) { xcd_barrier_complete(bar, bxx, nloc, nx); b.st[0] = nloc; b.st[1] = nx; }
        const unsigned old = xb_add(&bar[XB_XSUB(bxx)], 1u);
        const unsigned gen = old / nloc;
        if (old + 1u == (gen + 1u) * nloc) {
            __builtin_amdgcn_fence(__ATOMIC_RELEASE, "agent");
            asm volatile("s_waitcnt vmcnt(0)" ::: "memory");
            const unsigned og = xb_add(&bar[XB_TOP], 1u);
            const unsigned tg = og / nx;
            if (og + 1u == (tg + 1u) * nx) xb_add(&bar[XB_TOPGEN], 1u);
            else XB_SPIN(xb_ld(&bar[XB_TOPGEN]) == tg, bar);
            __builtin_amdgcn_fence(__ATOMIC_ACQUIRE, "agent");
            xb_add(&bar[XB_XGEN(bxx)], 1u);
            asm volatile("s_waitcnt vmcnt(0)" ::: "memory");
        } else {
            XB_SPIN(xb_ld(&bar[XB_XGEN(bxx)]) == gen, bar);
            __builtin_amdgcn_fence(__ATOMIC_ACQUIRE, "agent");
            asm volatile("s_waitcnt vmcnt(0)" ::: "memory");
        }
    }
    __syncthreads();
}

struct Args { const float* in[30]; float* out; unsigned char* ws; };
struct Frame {
    LAS unsigned char* lds; int vcu, G; float* out; unsigned char* ws; unsigned char* ob;
};
__device__ __forceinline__ const float* inp(const Frame& F, int i) {
    const LAS unsigned* t = (const LAS unsigned*)(F.lds + INTAB_OFF) + 2 * i; const unsigned lo = __builtin_amdgcn_readfirstlane(t[0]), hi = __builtin_amdgcn_readfirstlane(t[1]);
    return (const float*)(((unsigned long long)hi << 32) | lo); }
__device__ __forceinline__ float wave_sum(float v) {
#pragma unroll
    for (int o = 1; o < 64; o <<= 1) v += __shfl_xor(v, o);
    return v;
}

__device__ __forceinline__ int rowmap(int mode, int t) {
    if (mode == 1) { const int th = t & 255, half = th >> 7, w = th & 127, i = w & 63, hi = w >> 6; return (t & ~255) + 8 * ((half << 4) + (i >> 2)) + 4 * hi + (i & 3); }
    if (mode == 2) { const int th = t & 63, half = th >> 5, w = th & 31, i = w & 15, hi = w >> 4; return (t & ~63) + 8 * ((half << 2) + (i >> 2)) + 4 * hi + (i & 3); }
    if (mode == 3) { const int isg = t >= DFF ? 1 : 0; const int tt = isg ? t - DFF : t; return 8 * (tt >> 2) + 4 * isg + (tt & 3); }
    return t;
}
__device__ __forceinline__ void transpose_item(const float* W, int K, int N, bf16_t* WT, int row_off, int mode, LAS float* scr, int item, int lane) {
    const int nblk = N / 64, kb = item / nblk, nb = item % nblk, k0 = 64 * kb, n0 = 64 * nb;
    const int c4 = lane & 15, rr = lane >> 4;
    f32x4 v[16];
    const float* src = W + (size_t)(k0 + rr) * N + n0 + 4 * c4;
#pragma unroll
    for (int i = 0; i < 16; ++i) v[i] = *(const f32x4*)(src + (size_t)(4 * i) * N);
#pragma unroll
    for (int i = 0; i < 16; ++i) { LAS float* d = scr + (4 * i + rr) * 65 + 4 * c4; d[0] = v[i][0]; d[1] = v[i][1]; d[2] = v[i][2]; d[3] = v[i][3]; }
    asm volatile("s_waitcnt lgkmcnt(0)" ::: "memory");
    const int c = lane & 7;
#pragma unroll
    for (int j = 0; j < 8; ++j) { const int n = (lane >> 3) + 8 * j; const LAS float* s = scr + (8 * c) * 65 + n;
        u32x4 o; o.x = cvtpk(s[0 * 65], s[1 * 65]); o.y = cvtpk(s[2 * 65], s[3 * 65]); o.z = cvtpk(s[4 * 65], s[5 * 65]); o.w = cvtpk(s[6 * 65], s[7 * 65]);
        *(u32x4*)(WT + (size_t)(row_off + rowmap(mode, n0 + n)) * K + k0 + 8 * c) = o; }
    asm volatile("s_waitcnt lgkmcnt(0)" ::: "memory");
}
struct TrJob { const float* W; int K, N; bf16_t* WT; int row_off, mode, nitems; };
template <int NJ> __device__ __forceinline__ void run_transposes(const TrJob (&jobs)[NJ], LAS float* scr, int gw, int NGW, int lane) {
    int total = 0;
#pragma unroll
    for (int j = 0; j < NJ; ++j) total += jobs[j].nitems;
    for (int it = gw; it < total; it += NGW) {
        int r = it;
#pragma unroll
        for (int j = 0; j < NJ; ++j) { if (r >= 0 && r < jobs[j].nitems) { transpose_item(jobs[j].W, jobs[j].K, jobs[j].N, jobs[j].WT, jobs[j].row_off, jobs[j].mode, scr, r, lane); } r -= jobs[j].nitems; }
    }
}

__device__ __forceinline__ void p0_prologue(Frame& F, bool dry = false) {
    PHASE_IDS();
    LAS float* scr = (LAS float*)(F.lds + wid * 16640);
    const int gw = F.vcu * NWAVES + wid, NGW = F.G * NWAVES;
    float* mod = (float*)(F.ws + CTL_MOD_B);
    { const float* cvp = inp(F, 6); const float* ccp = inp(F, 7); const float* wbase = inp(F, 8); const float* bbase = inp(F, 9);
    for (int it = gw; it < 1536; it += NGW) {
        const int kq = it & 7, jb = (it >> 3) % 96, l = it / 768, j0 = jb * 64; const float* W = wbase + ((size_t)l * 1024 + kq * 128) * 6144 + j0 + lane;
        float acc[9]; const float bias = kq == 0 ? bbase[l * 6144 + j0 + lane] : 0.0f;
#pragma unroll
        for (int mb = 0; mb < 9; ++mb) acc[mb] = bias;
#pragma unroll 1
        for (int kb = 0; kb < 2; ++kb) {
            float sreg[9];
#pragma unroll
            for (int mb = 0; mb < 9; ++mb) { const float cv = mb < 8 ? cvp[mb * 1024 + kq * 128 + kb * 64 + lane] : ccp[kq * 128 + kb * 64 + lane]; sreg[mb] = cv / (1.0f + expf(-cv)); }
            float wv[64];
#pragma unroll
            for (int kk = 0; kk < 64; ++kk) wv[kk] = W[(size_t)(kb * 64 + kk) * 6144];
#pragma unroll
            for (int kk = 0; kk < 64; ++kk) {
#pragma unroll
                for (int mb = 0; mb < 9; ++mb) acc[mb] += __uint_as_float(__builtin_amdgcn_readlane(__float_as_uint(sreg[mb]), kk)) * wv[kk]; }
        }
#pragma unroll
        for (int mb = 0; mb < 9; ++mb) { if (!dry) atomicAdd(mod + (l * 9 + mb) * 6144 + j0 + lane, acc[mb]); else asm volatile("" :: "v"(acc[mb])); }
    } }
    { float* z0 = (float*)(F.ws + WS_NST); for (int e = gw * 64 + lane; e < 3 * MROWS; e += NGW * 64) z0[e] = 0.0f;
      float* z1 = (float*)(F.ws + WS_CB); for (int e = gw * 64 + lane; e < CB_TOTAL; e += NGW * 64) z1[e] = 0.0f; }
    { float* tr = (float*)(F.ws + WS_TABR); float* ta = (float*)(F.ws + WS_TABA);
      for (int e = gw * 64 + lane; e < 4096 + 1024; e += NGW * 64) {
          if (e < 4096) { const int pos = e >> 6, i = e & 63; const float inv = powf(10000.0f, -(float)i / 64.0f); const float ang = (float)pos * inv; tr[2 * e] = cosf(ang); tr[2 * e + 1] = sinf(ang); }
          else { const int e2 = e - 4096, pos = e2 >> 4, i = e2 & 15; const float inv = powf(10000.0f, -(float)i / 16.0f); const float ang = (float)pos * inv; ta[2 * e2] = cosf(ang); ta[2 * e2 + 1] = sinf(ang); } } }
    { bf16_t* ck = (bf16_t*)(F.ws + WS_CK); bf16_t* cv = (bf16_t*)(F.ws + WS_CV);
      for (int e = (gw * 64 + lane) * 4; e < 524288; e += NGW * 64 * 4) {
          const f32x4 a = *(const f32x4*)(inp(F, 4) + e), b = *(const f32x4*)(inp(F, 5) + e);
          u32x2 wa = {cvtpk(a[0], a[1]), cvtpk(a[2], a[3])}, wb = {cvtpk(b[0], b[1]), cvtpk(b[2], b[3])};
          *(u32x2*)(ck + e) = wa; *(u32x2*)(cv + e) = wb; } }
    { bf16_t* w1t = (bf16_t*)(F.ob + OUT_W1T);
      const TrJob jobs[5] = { {inp(F, 12), 1024, 1024, w1t, 0, 1, 256}, {inp(F, 13), 1024, 1024, w1t, 1024, 1, 256}, {inp(F, 14), 1024, 2048, w1t, 2048, 0, 512},
                              {inp(F, 15), 1024, 2048, w1t, 4096, 0, 512}, {inp(F, 16), 1024, 2048, w1t, 6144, 0, 512} };
      run_transposes<5>(jobs, scr, gw, NGW, lane); }
}

__device__ __forceinline__ void bias_items(Frame& F, int gw, int NGW, int lane) {
    const float* modp = (const float*)(F.ws + CTL_MOD_B); float* cb = (float*)(F.ws + WS_CB);
    for (int it = gw; it < 1600; it += NGW) {
        int r = it; const float* W; int N, nblk; const float* sh; float* out; int ldo;
        if (r < 1408) { const int l = r / 704; r -= l * 704; W = inp(F, 25) + (size_t)l * 1024 * 5632; N = 5632; nblk = 88; sh = modp + (size_t)(l * 9) * 6144 + 3 * 1024; out = cb + (l ? CB_FFN1 : CB_FFN0); ldo = 5632; }
        else { r -= 1408; sh = modp + (size_t)9 * 6144; ldo = 1536;
            if (r < 128) { W = inp(F, 20); N = 1024; nblk = 16; out = cb + CB_QKV; }
            else if (r < 160) { r -= 128; W = inp(F, 21); N = 256; nblk = 4; out = cb + CB_QKV + 1024; }
            else { r -= 160; W = inp(F, 22); N = 256; nblk = 4; out = cb + CB_QKV + 1280; } }
        const int kq = r & 7, jb = r >> 3, j0 = jb * 64; (void)nblk;
        const float* Wp = W + (size_t)(kq * 128) * N + j0 + lane;
        float acc[9];
#pragma unroll
        for (int mb = 0; mb < 9; ++mb) acc[mb] = 0.0f;
#pragma unroll 1
        for (int kb = 0; kb < 2; ++kb) {
            float sreg[9];
#pragma unroll
            for (int mb = 0; mb < 9; ++mb) sreg[mb] = sh[mb * 6144 + kq * 128 + kb * 64 + lane];
            float wv[64];
#pragma unroll
            for (int kk = 0; kk < 64; ++kk) wv[kk] = Wp[(size_t)(kb * 64 + kk) * N];
#pragma unroll
            for (int kk = 0; kk < 64; ++kk) { const float wq = __uint_as_float(cvtpk(wv[kk], 0.f) << 16);
#pragma unroll
                for (int mb = 0; mb < 9; ++mb) acc[mb] += __uint_as_float(__builtin_amdgcn_readlane(__float_as_uint(sreg[mb]), kk)) * wq; }
        }
#pragma unroll
        for (int mb = 0; mb < 9; ++mb) atomicAdd(out + mb * ldo + j0 + lane, acc[mb]);
    }
}

__device__ __forceinline__ void modulate_rows(Frame& F, const float* xa, const float* xb, const float* g, const float* modl, int shc, int scc, bf16_t* Hout) {
    PHASE_IDS();
    const int gw = F.vcu * NWAVES + wid, NGW = F.G * NWAVES;
    for (int row0 = gw; row0 < MROWS; row0 += 2 * NGW) {
        const int row1 = row0 + NGW < MROWS ? row0 + NGW : row0;
        const float* s0p = row0 < NCTX ? xa + (size_t)row0 * 1024 : xb + (size_t)(row0 - NCTX) * 1024;
        const float* s1p = row1 < NCTX ? xa + (size_t)row1 * 1024 : xb + (size_t)(row1 - NCTX) * 1024;
        f32x4 v0[4], v1[4];
#pragma unroll
        for (int j = 0; j < 4; ++j) { v0[j] = *(const f32x4*)(s0p + 4 * (lane + 64 * j)); v1[j] = *(const f32x4*)(s1p + 4 * (lane + 64 * j)); }
#pragma unroll
        for (int rr = 0; rr < 2; ++rr) {
            const int row = rr ? row1 : row0; const int mb = row < NCTX ? 8 : ((row - NCTX) >> 11);
            float ss = 0.f;
#pragma unroll
            for (int j = 0; j < 4; ++j) { const f32x4 t = rr ? v1[j] : v0[j]; ss += (t[0] * t[0] + t[1] * t[1]) + (t[2] * t[2] + t[3] * t[3]); }
            const float rstd = 1.0f / sqrtf(wave_sum(ss) * (1.0f / 1024.0f) + EPSV);
            const float* sh = modl + mb * 6144 + shc * 1024; const float* sc = modl + mb * 6144 + scc * 1024;
            if (rr == 0 || row1 != row0) {
#pragma unroll
            for (int j = 0; j < 4; ++j) { const int col = 4 * (lane + 64 * j); const f32x4 gg = *(const f32x4*)(g + col), s1 = *(const f32x4*)(sc + col), s0 = *(const f32x4*)(sh + col);
                const f32x4 t = rr ? v1[j] : v0[j]; const f32x4 y = (t * rstd) * gg * (1.0f + s1) + s0; u32x2 w = {cvtpk(y[0], y[1]), cvtpk(y[2], y[3])}; *(u32x2*)(Hout + (size_t)row * 1024 + col) = w; } }
        }
    }
}
__device__ __forceinline__ void final_norm(Frame& F, const bf16_t* Xp, float* Yp, const float* g) {
    PHASE_IDS();
    const int gw = F.vcu * NWAVES + wid, NGW = F.G * NWAVES;
    for (int row0 = gw; row0 < MROWS; row0 += 2 * NGW) {
        const int row1 = row0 + NGW < MROWS ? row0 + NGW : row0;
        u32x4 w0[2], w1[2];
#pragma unroll
        for (int j = 0; j < 2; ++j) { w0[j] = *(const u32x4*)(Xp + (size_t)row0 * 1024 + 16 * lane + 8 * j); w1[j] = *(const u32x4*)(Xp + (size_t)row1 * 1024 + 16 * lane + 8 * j); }
#pragma unroll
        for (int rr = 0; rr < 2; ++rr) {
            float v[16];
#pragma unroll
            for (int j = 0; j < 2; ++j) { const u32x4 w = rr ? w1[j] : w0[j]; v[8 * j] = bflo(w.x); v[8 * j + 1] = bfhi(w.x); v[8 * j + 2] = bflo(w.y); v[8 * j + 3] = bfhi(w.y); v[8 * j + 4] = bflo(w.z); v[8 * j + 5] = bfhi(w.z); v[8 * j + 6] = bflo(w.w); v[8 * j + 7] = bfhi(w.w); }
            float ss = 0.f;
#pragma unroll
            for (int e = 0; e < 16; ++e) ss += v[e] * v[e];
            const float rstd = 1.0f / sqrtf(wave_sum(ss) * (1.0f / 1024.0f) + EPSV);
            if (rr == 0 || row1 != row0) { float* dst = Yp + (size_t)(rr ? row1 : row0) * 1024 + 16 * lane;
#pragma unroll
                for (int q = 0; q < 4; ++q) { const f32x4 gg = *(const f32x4*)(g + 16 * lane + 4 * q); *(f32x4*)(dst + 4 * q) = (f32x4){v[4 * q] * rstd * gg[0], v[4 * q + 1] * rstd * gg[1], v[4 * q + 2] * rstd * gg[2], v[4 * q + 3] * rstd * gg[3]}; } }
        }
    }
}

__device__ __forceinline__ s16x4 vtr(const LAS unsigned char* p) { return __builtin_bit_cast(s16x4, __builtin_amdgcn_ds_read_tr16_b64_v4i16((LAS v4i16_t*)p)); }
__device__ __forceinline__ bf16x8 cat8(s16x4 lo, s16x4 hi) { return __builtin_shufflevector(lo, hi, 0, 1, 2, 3, 4, 5, 6, 7); }
__device__ __forceinline__ bf16x8 pack8(const f32x16& x, int s) {
    u32x4 p; p.x = cvtpk(x[8 * s], x[8 * s + 1]); p.y = cvtpk(x[8 * s + 2], x[8 * s + 3]); p.z = cvtpk(x[8 * s + 4], x[8 * s + 5]); p.w = cvtpk(x[8 * s + 6], x[8 * s + 7]);
    return __builtin_bit_cast(bf16x8, p);
}
constexpr int RA = 0, RB = 32768, RC = 65536, RD = 98304;
#define RWAITV(n) asm volatile("s_waitcnt vmcnt(" #n ")" ::: "memory")
#define RBAR() do { asm volatile("s_waitcnt lgkmcnt(0)" ::: "memory"); __builtin_amdgcn_s_barrier(); asm volatile("" ::: "memory"); } while (0)
__device__ __forceinline__ void glds16(const void* gsrc, unsigned lds_dst) { unsigned keep;
    asm volatile("s_mov_b32 %0, m0\n\ts_mov_b32 m0, %2\n\ts_nop 0\n\tglobal_load_lds_dwordx4 %1, off\n\ts_mov_b32 m0, %0" : "=&s"(keep) : "v"(gsrc), "s"(lds_dst) : "memory"); }
#define RSTAGE(ldsoff, gptr, voff) do { _Pragma("unroll") for (int _i = 0; _i < 2; ++_i) \
    glds16((const char*)(gptr) + (voff)[_i], (unsigned)__builtin_amdgcn_readfirstlane((int)(lds0 + (ldsoff) + ldsw + _i * 8192))); } while (0)
__device__ __forceinline__ int dkl_of(int r, int h5) { const int q = r >> 2; return 16 * (q >> 1) + 8 * h5 + 4 * (q & 1) + (r & 3); }
__device__ __forceinline__ void retention_item3(Frame& F, int type, int b, int h, int dir, int sl, bool dry = false) {
    PHASE_IDS();
    const int g = wid >> 2, w = wid & 3;
    LAS unsigned char* L = F.lds;
    const bf16_t* Qg = (const bf16_t*)(F.ws + WS_Q); const bf16_t* Kg = (const bf16_t*)(F.ws + WS_K); const bf16_t* Vg = (const bf16_t*)(F.ws + WS_V);
    bf16_t* SG = dir ? (bf16_t*)(F.ob + OUT_SGB) : (bf16_t*)(F.ws + WS_SGF);
    float* stats = (float*)(F.ws + CTL_STATS_B);
    const int nch = type ? 16 : 2, rowbase = type ? NCTX + b * 2048 : b * 256;
    const float raw = (dir ? inp(F, 19) : inp(F, 18))[h];
    const float lg2_ = -log1pf(expf(-raw)) * LOG2E;
    const int jt = wid >> 1, it0 = 2 * (wid & 1);
    const unsigned ldsw = (unsigned)wid * 1024u; const unsigned lds0 = (unsigned)(uintptr_t)L;
    unsigned voffQ[2], voffV[2];
    { const int row = tid >> 3, xsr = (((row >> 1) & 1) << 2) | ((row >> 2) & 3), cs = (tid & 7) ^ xsr;
      voffQ[0] = (unsigned)(row * 1024 + 8 * cs) * 2u; voffQ[1] = voffQ[0] + 64u * 1024u * 2u; voffV[0] = (unsigned)(row * 2048 + 8 * cs) * 2u; voffV[1] = voffV[0] + 64u * 2048u * 2u; }
    f32x16 st[4];
    { const int n = lane & 31, h5 = lane >> 5;
      const float* S0 = (dir ? inp(F, 3) : inp(F, 2)) + (size_t)(b * 4 + h) * 256 * 512 + sl * 128 + 32 * w + n;
#pragma unroll
      for (int d = 0; d < 4; ++d)
#pragma unroll
          for (int r = 0; r < 16; ++r) st[d][r] = type ? S0[(size_t)(64 * d + 32 * g + dkl_of(r, h5)) * 512] : 0.0f; }
#define QSRC(c_, d_) ((const char*)(Qg + (size_t)(rowbase + 128 * (c_)) * 1024 + h * 256 + 64 * (d_)))
#define KSRC(c_, d_) ((const char*)(Kg + (size_t)(rowbase + 128 * (c_)) * 1024 + h * 256 + 64 * (d_)))
#define VSRC(c_, hv_) ((const char*)(Vg + (size_t)(rowbase + 128 * (c_)) * 2048 + h * 512 + sl * 128 + 64 * (hv_)))
    { const int c0 = dir ? nch - 1 : 0;
      asm volatile("s_waitcnt vmcnt(0) lgkmcnt(0)" ::: "memory"); __builtin_amdgcn_s_barrier();
      RSTAGE(RA, QSRC(c0, 0), voffQ); RSTAGE(RA + 16384, KSRC(c0, 0), voffQ); RSTAGE(RB, QSRC(c0, 1), voffQ); RSTAGE(RB + 16384, KSRC(c0, 1), voffQ);
      RSTAGE(RD, VSRC(c0, 0), voffV); RSTAGE(RD + 16384, VSRC(c0, 1), voffV);
      RWAITV(0); }
    for (int cc = 0; cc < nch; ++cc) {
        const int c = dir ? nch - 1 - cc : cc; const int R0 = rowbase + 128 * c;
        const int cn = cc + 1 < nch ? (dir ? c - 1 : c + 1) : c;
        int tl = tid; float lg2 = lg2_; asm volatile("" : "+v"(tl), "+v"(lg2));
        const int tid = tl, lane = tl & 63, n = lane & 31, h5 = lane >> 5, blk = (lane >> 4) & 1, q4 = (lane & 15) >> 2, p4 = lane & 3;
        const float g128 = __builtin_amdgcn_exp2f(lg2 * 128.0f);
        const int xn = (((n >> 1) & 1) << 2) | ((n >> 2) & 3), y16 = (xn ^ h5) << 4;
        int rs[4];
#pragma unroll
        for (int s = 0; s < 4; ++s) rs[s] = n * 128 + ((s << 5) ^ y16);
        const int rc[2] = {n * 128 + (((4 * g) << 4) ^ y16), n * 128 + (((4 * g + 2) << 4) ^ y16)};
        const int xr0 = (((q4 >> 1) & 1) << 2) | (2 * h5), xr1 = xr0 | 1;
        const int cV = 4 * (w & 1) + 2 * blk + (p4 >> 1), cK = 4 * g + 2 * blk + (p4 & 1);
        const int tv0 = (w >> 1) * 16384 + (8 * h5 + q4) * 128 + ((cV ^ xr0) << 4) + (p4 & 1) * 8, tv1 = (w >> 1) * 16384 + (8 * h5 + 4 + q4) * 128 + ((cV ^ xr1) << 4) + (p4 & 1) * 8;
        const int tk0 = (8 * h5 + q4) * 128 + ((cK ^ xr0) << 4) + (p4 >> 1) * 8, tk1 = (8 * h5 + 4 + q4) * 128 + ((cK ^ xr1) << 4) + (p4 >> 1) * 8;
        f32x16 oacc[4], X0, X1;
#pragma unroll
        for (int i = 0; i < 16; ++i) { oacc[0][i] = 0.f; oacc[1][i] = 0.f; oacc[2][i] = 0.f; oacc[3][i] = 0.f; X0[i] = 0.f; X1[i] = 0.f; }
#define LDQK(s_, BUF, A_, B0_, B1_) do { A_ = *(const LAS bf16x8*)(L + (BUF) + 16384 + 4096 * jt + rs[s_]); B0_ = *(const LAS bf16x8*)(L + (BUF) + 4096 * it0 + rs[s_]); B1_ = *(const LAS bf16x8*)(L + (BUF) + 4096 * (it0 + 1) + rs[s_]); } while (0)
#define LDCR(s_, BUF, C_) do { _Pragma("unroll") for (int it = 0; it < 4; ++it) C_[it] = *(const LAS bf16x8*)(L + (BUF) + 4096 * it + rc[s_]); } while (0)
#define R3_TILE1(d, BUF) do { bf16x8 a0, b00, b01, a1, b10, b11, cfr[4], dfr[4]; \
        LDQK(0, BUF, a0, b00, b01); LDQK(1, BUF, a1, b10, b11); \
        X0 = MFMA32(a0, b00, X0); X1 = MFMA32(a0, b01, X1); PINV(X0); PINV(X1); FENCE(); \
        LDQK(2, BUF, a0, b00, b01); \
        X0 = MFMA32(a1, b10, X0); X1 = MFMA32(a1, b11, X1); PINV(X0); PINV(X1); FENCE(); \
        LDQK(3, BUF, a1, b10, b11); LDCR(0, BUF, cfr); \
        X0 = MFMA32(a0, b00, X0); X1 = MFMA32(a0, b01, X1); PINV(X0); PINV(X1); FENCE(); \
        X0 = MFMA32(a1, b10, X0); X1 = MFMA32(a1, b11, X1); PINV(X0); PINV(X1); FENCE(); \
        LDCR(1, BUF, dfr); \
        { const bf16x8 bfr = pack8(st[d], 0); _Pragma("unroll") for (int it = 0; it < 4; ++it) oacc[it] = MFMA32(cfr[it], bfr, oacc[it]); } \
        PINV(oacc[0]); PINV(oacc[1]); PINV(oacc[2]); PINV(oacc[3]); FENCE(); \
        { const bf16x8 bfr = pack8(st[d], 1); _Pragma("unroll") for (int it = 0; it < 4; ++it) oacc[it] = MFMA32(dfr[it], bfr, oacc[it]); } \
        PINV(oacc[0]); PINV(oacc[1]); PINV(oacc[2]); PINV(oacc[3]); FENCE(); } while (0)
        RWAITV(8);
        RBAR();
        RSTAGE(RC, QSRC(c, 2), voffQ); RSTAGE(RC + 16384, KSRC(c, 2), voffQ);
        {
            const int hv = tid >> 8, bo = (tid & 255) * 64; const int R = bo >> 7;
            const float pj = (float)(dir ? 127 - R : R); const float zeta = __builtin_amdgcn_exp2f(lg2 * (127.0f - pj));
            LAS u32x4* vp = (LAS u32x4*)(L + RD + hv * 16384 + bo);
#pragma unroll
            for (int ii = 0; ii < 4; ++ii) { const u32x4 vv = vp[ii]; u32x4 z;
                z.x = cvtpk(bflo(vv.x) * zeta, bfhi(vv.x) * zeta); z.y = cvtpk(bflo(vv.y) * zeta, bfhi(vv.y) * zeta); z.z = cvtpk(bflo(vv.z) * zeta, bfhi(vv.z) * zeta); z.w = cvtpk(bflo(vv.w) * zeta, bfhi(vv.w) * zeta);
                vp[ii] = z; }
        }
        if (!(dry && (RET_ABL & 1))) R3_TILE1(0, RA);
        RWAITV(4); RBAR();
        RSTAGE(RA, QSRC(c, 3), voffQ); RSTAGE(RA + 16384, KSRC(c, 3), voffQ);
        if (!(dry && (RET_ABL & 1))) R3_TILE1(1, RB);
        RWAITV(4); RBAR();
        RSTAGE(RB + 16384, KSRC(c, 0), voffQ);
        if (!(dry && (RET_ABL & 1))) R3_TILE1(2, RC);
        RWAITV(2); RBAR();
        RSTAGE(RC + 16384, KSRC(c, 1), voffQ);
        if (!(dry && (RET_ABL & 1))) R3_TILE1(3, RA);
        { const float sg = dir ? -lg2 : lg2; const float e0 = dir ? (float)(128 - 4 * h5) : (float)(4 * h5 + 1);
          float fa[4], fb[4], fc[4], fbc[16];
#pragma unroll
          for (int q = 0; q < 4; ++q) { fa[q] = __builtin_amdgcn_exp2f(sg * (float)(32 * q)); fb[q] = __builtin_amdgcn_exp2f(sg * (float)(8 * q)); fc[q] = __builtin_amdgcn_exp2f(lg2 * e0 + sg * (float)q); }
#pragma unroll
          for (int r = 0; r < 16; ++r) fbc[r] = fb[r >> 2] * fc[r & 3];
#pragma unroll
          for (int it = 0; it < 4; ++it)
#pragma unroll
              for (int r = 0; r < 16; ++r) oacc[it][r] *= fa[it] * fbc[r]; }
        RBAR();
        RSTAGE(RB, KSRC(c, 2), voffQ); RSTAGE(RC, KSRC(c, 3), voffQ);
#pragma unroll
        for (int tt = 0; tt < 2; ++tt) {
            const int i = 32 * (it0 + tt) + n; const float ui = __builtin_amdgcn_exp2f(lg2 * (float)((dir ? 127 - i : i) - 127));
#pragma unroll
            for (int r4 = 0; r4 < 4; ++r4) { const int j0 = 32 * jt + 8 * r4 + 4 * h5; float vv[4];
#pragma unroll
                for (int e = 0; e < 4; ++e) { const int j = j0 + e; const int dd = dir ? j - i : i - j; const float x = tt ? X1[4 * r4 + e] : X0[4 * r4 + e]; vv[e] = dd >= 0 ? x * ui : 0.0f; }
                u32x2 wv = {cvtpk(vv[0], vv[1]), cvtpk(vv[2], vv[3])};
                *(LAS u32x2*)(L + RA + (jt >> 1) * 16384 + i * 128 + (((4 * (jt & 1) + r4) ^ xn) << 4) + 8 * h5) = wv; }
        }
#pragma unroll
        for (int d = 0; d < 4; ++d)
#pragma unroll
            for (int r = 0; r < 16; ++r) st[d][r] *= g128;
        RBAR();
        if (!(dry && (RET_ABL & 4))) {
            bf16x8 pf[2][4], vf[2];
#define LDIN(ks_, slot_) do { const LAS unsigned char* vb_ = L + RD + 8192 * g + 2048 * (ks_); vf[slot_] = cat8(vtr(vb_ + tv0), vtr(vb_ + tv1)); \
            _Pragma("unroll") for (int it = 0; it < 4; ++it) pf[slot_][it] = *(const LAS bf16x8*)(L + RA + 16384 * g + 4096 * it + rs[ks_]); } while (0)
            LDIN(0, 0);
#pragma unroll
            for (int ks = 0; ks < 4; ++ks) {
                if (ks < 3) { if (ks & 1) LDIN((ks + 1) & 3, 0); else LDIN((ks + 1) & 3, 1); }
#pragma unroll
                for (int it = 0; it < 4; ++it) oacc[it] = MFMA32(pf[ks & 1][it], vf[ks & 1], oacc[it]);
                PINV(oacc[0]); PINV(oacc[1]); PINV(oacc[2]); PINV(oacc[3]); FENCE();
            }
#undef LDIN
        }
        RWAITV(0); RBAR();
        RSTAGE(RA, QSRC(cn, 0), voffQ); RSTAGE(RA + 16384, KSRC(cn, 0), voffQ);
        const int cu = tid >> 4, cw2 = (tid >> 2) & 3, cnq = tid & 3;
        bf16_t* zp = SG + (size_t)(R0 + 4 * cu) * 2048 + h * 512 + sl * 128 + 32 * cw2 + 8 * cnq;
        u32x4 gv[4];
#pragma unroll
        for (int e = 0; e < 4; ++e) gv[e] = *(const u32x4*)(zp + (size_t)e * 2048);
        if (!(dry && (RET_ABL & 2))) {
            bf16x8 kf[2][4], zf[2];
#define LDST(ks_, slot_) do { const LAS unsigned char* zb_ = L + RD + 2048 * (ks_); zf[slot_] = cat8(vtr(zb_ + tv0), vtr(zb_ + tv1)); \
            kf[slot_][0] = cat8(vtr(L + RB + 16384 + 2048 * (ks_) + tk0), vtr(L + RB + 16384 + 2048 * (ks_) + tk1)); kf[slot_][1] = cat8(vtr(L + RC + 16384 + 2048 * (ks_) + tk0), vtr(L + RC + 16384 + 2048 * (ks_) + tk1)); \
            kf[slot_][2] = cat8(vtr(L + RB + 2048 * (ks_) + tk0), vtr(L + RB + 2048 * (ks_) + tk1)); kf[slot_][3] = cat8(vtr(L + RC + 2048 * (ks_) + tk0), vtr(L + RC + 2048 * (ks_) + tk1)); } while (0)
            LDST(0, 0);
#pragma unroll
            for (int ks = 0; ks < 8; ++ks) {
                if (ks < 7) { if (ks & 1) LDST((ks + 1) & 7, 0); else LDST((ks + 1) & 7, 1); }
#pragma unroll
                for (int d = 0; d < 4; ++d) st[d] = MFMA32(kf[ks & 1][d], zf[ks & 1], st[d]);
                PINV(st[0]); PINV(st[1]); PINV(st[2]); PINV(st[3]); FENCE();
            }
#undef LDST
        }
        RBAR();
        RSTAGE(RB, QSRC(cn, 1), voffQ); RSTAGE(RB + 16384, KSRC(cn, 1), voffQ);
        RSTAGE(RD, VSRC(cn, 0), voffV); RSTAGE(RD + 16384, VSRC(cn, 1), voffV);
        if (g == 1 && !(dry && (RET_ABL & 8))) {
#pragma unroll
            for (int it = 0; it < 4; ++it)
#pragma unroll
                for (int r4 = 0; r4 < 4; ++r4) { const int u = 8 * it + 2 * r4 + h5; u32x2 pk = {cvtpk(oacc[it][4 * r4], oacc[it][4 * r4 + 1]), cvtpk(oacc[it][4 * r4 + 2], oacc[it][4 * r4 + 3])};
                    *(LAS u32x2*)(L + RC + (w * 32 + n) * 256 + ((u ^ n ^ (w << 1)) << 3)) = pk; }
        }
        RBAR();
        if (g == 0 && !(dry && (RET_ABL & 8))) {
#pragma unroll
            for (int it = 0; it < 4; ++it)
#pragma unroll
                for (int r4 = 0; r4 < 4; ++r4) { const int u = 8 * it + 2 * r4 + h5; LAS u32x2* p = (LAS u32x2*)(L + RC + (w * 32 + n) * 256 + ((u ^ n ^ (w << 1)) << 3)); const u32x2 o = *p;
                    u32x2 pk = {cvtpk(bflo(o.x) + oacc[it][4 * r4], bfhi(o.x) + oacc[it][4 * r4 + 1]), cvtpk(bflo(o.y) + oacc[it][4 * r4 + 2], bfhi(o.y) + oacc[it][4 * r4 + 3])};
                    *p = pk; }
        }
        RBAR();
        {
          float o[4][8]; float ss[4] = {0.f, 0.f, 0.f, 0.f};
#pragma unroll
          for (int e = 0; e < 8; ++e) { const int nn = 8 * cnq + e; const u32x2 v2 = *(const LAS u32x2*)(L + RC + (cw2 * 32 + nn) * 256 + ((cu ^ nn ^ (cw2 << 1)) << 3));
              o[0][e] = bflo(v2.x); o[1][e] = bfhi(v2.x); o[2][e] = bflo(v2.y); o[3][e] = bfhi(v2.y); }
#pragma unroll
          for (int rr = 0; rr < 4; ++rr) {
#pragma unroll
              for (int e = 0; e < 8; ++e) ss[rr] += o[rr][e] * o[rr][e];
              ss[rr] += __shfl_xor(ss[rr], 1); ss[rr] += __shfl_xor(ss[rr], 2); ss[rr] += __shfl_xor(ss[rr], 4); ss[rr] += __shfl_xor(ss[rr], 8); }
          RWAITV(8);
          if ((tid & 15) == 0 && !dry) {
#pragma unroll
              for (int rr = 0; rr < 4; ++rr) atomicAdd(stats + ((size_t)(R0 + 4 * cu + rr) * 4 + h) * 2 + dir, ss[rr]); }
          if (!dry) {
#pragma unroll
              for (int rr = 0; rr < 4; ++rr) { const u32x4 gq = gv[rr]; u32x4 z;
                  z.x = cvtpk(o[rr][0] * bflo(gq.x), o[rr][1] * bfhi(gq.x)); z.y = cvtpk(o[rr][2] * bflo(gq.y), o[rr][3] * bfhi(gq.y));
                  z.z = cvtpk(o[rr][4] * bflo(gq.z), o[rr][5] * bfhi(gq.z)); z.w = cvtpk(o[rr][6] * bflo(gq.w), o[rr][7] * bfhi(gq.w));
                  *(u32x4*)(zp + (size_t)rr * 2048) = z; } }
          else { asm volatile("" :: "v"(gv[0]), "v"(gv[1]), "v"(gv[2]), "v"(gv[3])); } }
    }
    if (type == 0) {
        const int n = lane & 31, h5 = lane >> 5;
        float* So = (float*)(F.ob + (dir ? OUT_SB : OUT_SF)) + (size_t)(b * 4 + h) * 256 * 512 + sl * 128 + 32 * w + n;
#pragma unroll
        for (int d = 0; d < 4; ++d)
#pragma unroll
            for (int r = 0; r < 16; ++r) So[(size_t)(64 * d + 32 * g + dkl_of(r, h5)) * 512] = st[d][r];
    }
    asm volatile("s_waitcnt vmcnt(0) lgkmcnt(0)" ::: "memory");
#undef QSRC
#undef KSRC
#undef VSRC
#undef LDQK
#undef LDCR
#undef R3_TILE1
}
__device__ __forceinline__ void retention_phase(Frame& F, bool dry = false) {
    for (int it = F.vcu; it < 1280; it += F.G) {
        if (it < 256) retention_item3(F, 1, it >> 5, (it >> 3) & 3, (it >> 2) & 1, it & 3, dry);
        else { const int i2 = it - 256; retention_item3(F, 0, i2 >> 5, (i2 >> 3) & 3, (i2 >> 2) & 1, i2 & 3, dry); }
    }
}
__device__ __forceinline__ void combine_rows(Frame& F) {
    PHASE_IDS();
    const int gw = F.vcu * NWAVES + wid, NGW = F.G * NWAVES;
    const bf16_t* zf = (const bf16_t*)(F.ws + WS_SGF); const bf16_t* zb = (const bf16_t*)(F.ob + OUT_SGB); bf16_t* Y = (bf16_t*)(F.ws + WS_Y);
    const float* stats = (const float*)(F.ws + CTL_STATS_B);
    for (int row0 = gw; row0 < MROWS; row0 += 2 * NGW) {
        const int row1 = row0 + NGW < MROWS ? row0 + NGW : row0; const int h = lane >> 4;
        u32x4 a[2][4], c[2][4]; float sf[2], sb[2];
#pragma unroll
        for (int rr = 0; rr < 2; ++rr) { const int row = rr ? row1 : row0; const size_t off = (size_t)row * 2048 + lane * 32;
            sf[rr] = stats[((size_t)row * 4 + h) * 2]; sb[rr] = stats[((size_t)row * 4 + h) * 2 + 1];
#pragma unroll
            for (int e = 0; e < 4; ++e) { a[rr][e] = *(const u32x4*)(zf + off + 8 * e); c[rr][e] = *(const u32x4*)(zb + off + 8 * e); } }
#pragma unroll
        for (int rr = 0; rr < 2; ++rr) { const int row = rr ? row1 : row0; const size_t off = (size_t)row * 2048 + lane * 32;
            const float rf = 1.0f / sqrtf(sf[rr] * (1.0f / 512.0f) + EPSV), rb = 1.0f / sqrtf(sb[rr] * (1.0f / 512.0f) + EPSV);
            if (rr == 0 || row1 != row0) {
#pragma unroll
            for (int e = 0; e < 4; ++e) { const u32x4 p = a[rr][e], q = c[rr][e]; u32x4 y;
                y.x = cvtpk(rf * bflo(p.x) + rb * bflo(q.x), rf * bfhi(p.x) + rb * bfhi(q.x)); y.y = cvtpk(rf * bflo(p.y) + rb * bflo(q.y), rf * bfhi(p.y) + rb * bfhi(q.y));
                y.z = cvtpk(rf * bflo(p.z) + rb * bflo(q.z), rf * bfhi(p.z) + rb * bfhi(q.z)); y.w = cvtpk(rf * bflo(p.w) + rb * bflo(q.w), rf * bfhi(p.w) + rb * bfhi(q.w));
                *(u32x4*)(Y + off + 8 * e) = y; } }
        }
    }
}

constexpr int A2_K = 0, A2_V = 24576, A2_WS = 49152, A2_OST = 53248;
__device__ __forceinline__ void attn_item2(Frame& F, int type, int b, int kh, int qb, int abl = 0) {
    PHASE_IDS();
    const int n = lane & 31, h5 = lane >> 5, blk = (lane >> 4) & 1, q4 = (lane & 15) >> 2, p4 = lane & 3;
    LAS unsigned char* L = F.lds; LAS float* wsf = (LAS float*)(L + A2_WS) + wid * 32;
    const unsigned lds0 = (unsigned)(uintptr_t)L;
    const bf16_t* AQ = (const bf16_t*)(F.ws + WS_AQ); const bf16_t* AK = (const bf16_t*)(F.ws + WS_AK); const bf16_t* AV = (const bf16_t*)(F.ws + WS_AV);
    const bf16_t* CK = (const bf16_t*)(F.ws + WS_CK); const bf16_t* CV = (const bf16_t*)(F.ws + WS_CV); bf16_t* AO = (bf16_t*)(F.ws + WS_AO);
    const int gq = wid >> 1, rh = wid & 1, head = kh * 4 + gq;
    const int seq0 = type ? NCTX + b * 2048 : b * 256; const int qrow0 = seq0 + 64 * qb;
    int blo = 0, bhi = -1;
    if (type) { blo = qb - 2 < 0 ? 0 : qb - 2; bhi = qb + 2 > 31 ? 31 : qb + 2; }
    const int ntile = 4 + (type ? bhi - blo + 1 : 0);
    const int drow = tid >> 3, dxs = (((drow >> 1) & 1) << 2) | ((drow >> 2) & 3);
    const unsigned dvoff = (unsigned)(drow * 256 + 8 * ((tid & 7) ^ dxs)) * 2u;
    const unsigned ldsw = (unsigned)wid * 1024u;
#define A2_SRC(t_, KP, VP) do { const int t2_ = (t_); const bool band_ = t2_ >= 4; const int kt_ = band_ ? blo + (t2_ - 4) : t2_; \
        if (type == 0) { KP = (const char*)(AK + (size_t)(seq0 + 64 * kt_) * 256 + kh * 64); VP = (const char*)(AV + (size_t)(seq0 + 64 * kt_) * 256 + kh * 64); } \
        else if (!band_) { KP = (const char*)(CK + (size_t)(b * 256 + 64 * kt_) * 256 + kh * 64); VP = (const char*)(CV + (size_t)(b * 256 + 64 * kt_) * 256 + kh * 64); } \
        else { KP = (const char*)(AK + (size_t)(seq0 + 64 * kt_) * 256 + kh * 64); VP = (const char*)(AV + (size_t)(seq0 + 64 * kt_) * 256 + kh * 64); } } while (0)
#define A2_ISSUE(t_) do { const char* kp_; const char* vp_; const int tt_ = (t_) < ntile ? (t_) : ntile - 1; A2_SRC(tt_, kp_, vp_); const int slot_ = (t_) % 3; \
        glds16(kp_ + dvoff, (unsigned)__builtin_amdgcn_readfirstlane((int)(lds0 + A2_K + slot_ * 8192 + ldsw))); \
        glds16(vp_ + dvoff, (unsigned)__builtin_amdgcn_readfirstlane((int)(lds0 + A2_V + slot_ * 8192 + ldsw))); } while (0)
    asm volatile("s_waitcnt vmcnt(0) lgkmcnt(0)" ::: "memory"); __builtin_amdgcn_s_barrier();
    A2_ISSUE(0); A2_ISSUE(1);
    bf16x8 qf[4];
#pragma unroll
    for (int s = 0; s < 4; ++s) qf[s] = *(const bf16x8*)(AQ + (size_t)(qrow0 + 32 * rh + n) * 1024 + head * 64 + 16 * s + 8 * h5);
    asm volatile("s_waitcnt vmcnt(0)" : "+v"(qf[0]), "+v"(qf[1]), "+v"(qf[2]), "+v"(qf[3]) :: "memory");
    float mrun = 0.f, lrun = 0.f; f32x16 o0, o1, negm;
#pragma unroll
    for (int i = 0; i < 16; ++i) { o0[i] = 0.f; o1[i] = 0.f; negm[i] = 0.f; }
    const int xn = (((n >> 1) & 1) << 2) | ((n >> 2) & 3), y16 = (xn ^ h5) << 4;
    int rs[4];
#pragma unroll
    for (int s = 0; s < 4; ++s) rs[s] = n * 128 + ((s << 5) ^ y16);
    const int xlo = (((q4 >> 1) & 1) << 2) | h5, xhi = xlo | 2;
    int tvl[2], tvh[2];
#pragma unroll
    for (int c = 0; c < 2; ++c) { const int ch = 4 * c + 2 * blk + (p4 >> 1); tvl[c] = (4 * h5 + q4) * 128 + ((ch ^ xlo) << 4) + (p4 & 1) * 8; tvh[c] = (8 + 4 * h5 + q4) * 128 + ((ch ^ xhi) << 4) + (p4 & 1) * 8; }
    const float sink2 = inp(F, 24)[head] * LOG2E;
    for (int t = 0; t < ntile; ++t) {
        const bool band = t >= 4; const int kt = band ? blo + (t - 4) : t; const int slot = t % 3;
        asm volatile("s_waitcnt vmcnt(2)" ::: "memory"); RBAR();
        A2_ISSUE(t + 2);
        if (abl & 1) continue;
        const LAS unsigned char* Kt = L + A2_K + slot * 8192; const LAS unsigned char* Vt = L + A2_V + slot * 8192;
        f32x16 p0 = negm, p1 = negm;
#pragma unroll
        for (int s = 0; s < 4; ++s) {
            const bf16x8 a0 = *(const LAS bf16x8*)(Kt + rs[s]), a1 = *(const LAS bf16x8*)(Kt + 4096 + rs[s]);
            p0 = MFMA32(a0, qf[s], p0); p1 = MFMA32(a1, qf[s], p1);
        }
        if (band && (kt == qb - 2 || kt == qb + 2)) { const int qp = 64 * qb + 32 * rh + n;
#pragma unroll
            for (int r = 0; r < 16; ++r) { const int kp = 64 * kt + crow(r, h5); int d0 = qp - kp; d0 = d0 < 0 ? -d0 : d0; int d1 = qp - kp - 32; d1 = d1 < 0 ? -d1 : d1;
                if (d0 > 128) p0[r] = -1e30f; if (d1 > 128) p1[r] = -1e30f; } }
        float mx = __builtin_fmaxf(__builtin_fmaxf(p0[0], p0[1]), p1[0]), mx2 = __builtin_fmaxf(__builtin_fmaxf(p0[2], p0[3]), p1[1]);
        mx = __builtin_fmaxf(__builtin_fmaxf(mx, p1[2]), p1[3]);
#pragma unroll
        for (int r = 4; r < 16; r += 4) { mx = __builtin_fmaxf(__builtin_fmaxf(mx, p0[r]), p0[r + 1]); mx2 = __builtin_fmaxf(__builtin_fmaxf(mx2, p0[r + 2]), p0[r + 3]);
            mx = __builtin_fmaxf(__builtin_fmaxf(mx, p1[r]), p1[r + 1]); mx2 = __builtin_fmaxf(__builtin_fmaxf(mx2, p1[r + 2]), p1[r + 3]); }
        mx = __builtin_fmaxf(mx, mx2);
        mx = __builtin_fmaxf(mx, __shfl_xor(mx, 32));
        const bool resc = (t == 0) || __any(mx > 8.0f);
        float f = 1.0f;
        if (resc) { const float dl = (t == 0) ? mx : __builtin_fmaxf(mx, 0.0f); mrun = (t == 0) ? dl : mrun + dl; f = (t == 0) ? 0.0f : __builtin_amdgcn_exp2f(-dl);
#pragma unroll
            for (int r = 0; r < 16; ++r) { p0[r] -= dl; p1[r] -= dl; negm[r] = -mrun; } }
        float ls = 0.f;
#pragma unroll
        for (int r = 0; r < 16; ++r) { p0[r] = __builtin_amdgcn_exp2f(p0[r]); p1[r] = __builtin_amdgcn_exp2f(p1[r]); ls += p0[r] + p1[r]; }
        ls += __shfl_xor(ls, 32);
        lrun = lrun * f + ls;
        if (resc) {
            if (h5 == 0) wsf[n] = f;
            asm volatile("s_waitcnt lgkmcnt(0)" ::: "memory");
#pragma unroll
            for (int r = 0; r < 16; ++r) { const float fr_ = wsf[crow(r, h5)]; o0[r] *= fr_; o1[r] *= fr_; }
            asm volatile("s_waitcnt lgkmcnt(0)" ::: "memory");
        }
#pragma unroll
        for (int tk = 0; tk < 2; ++tk)
#pragma unroll
            for (int s = 0; s < 2; ++s) {
                const bf16x8 af = tk ? pack8(p1, s) : pack8(p0, s);
                const LAS unsigned char* vb = Vt + (32 * tk + 16 * s) * 128;
                o0 = MFMA32(af, cat8(vtr(vb + tvl[0]), vtr(vb + tvh[0])), o0);
                o1 = MFMA32(af, cat8(vtr(vb + tvl[1]), vtr(vb + tvh[1])), o1);
            }
    }
    lrun += __builtin_amdgcn_exp2f(sink2 - mrun);
    const float inv = 1.0f / lrun;
    if (h5 == 0) wsf[n] = inv;
    asm volatile("s_waitcnt lgkmcnt(0)" ::: "memory");
    { LAS bf16_t* stg = (LAS bf16_t*)(L + A2_OST) + wid * 2048;
#pragma unroll
      for (int r = 0; r < 16; ++r) { const float iv = wsf[crow(r, h5)]; const int orow = crow(r, h5);
          stg[orow * 64 + n] = (bf16_t)(cvtpk(o0[r] * iv, 0.f) & 0xffffu); stg[orow * 64 + 32 + n] = (bf16_t)(cvtpk(o1[r] * iv, 0.f) & 0xffffu); }
      asm volatile("s_waitcnt lgkmcnt(0)" ::: "memory");
      if (!(abl & 2)) {
#pragma unroll
          for (int i = 0; i < 4; ++i) { const int row = i * 8 + (lane >> 3), ch = lane & 7; const u32x4 v = *(const LAS u32x4*)(stg + row * 64 + ch * 8);
              *(u32x4*)(AO + (size_t)(qrow0 + 32 * rh + row) * 1024 + head * 64 + ch * 8) = v; } } }
    asm volatile("s_waitcnt vmcnt(0) lgkmcnt(0)" ::: "memory");
#undef A2_SRC
#undef A2_ISSUE
}
__device__ __forceinline__ void attn_phase(Frame& F, int abl = 0) {
    for (int it = F.vcu; it < 1536; it += F.G) {
        if (it < 1024) attn_item2(F, 1, it >> 7, (it >> 5) & 3, it & 31, abl);
        else { const int i2 = it - 1024; attn_item2(F, 0, i2 >> 4, (i2 >> 2) & 3, i2 & 3, abl); }
    }
}

#define GRID_BAR() do { xcd_barrier(bar); asm volatile("" : "+s"(F.ws), "+s"(F.ob), "+s"(F.vcu), "+s"(F.G), "+s"(bx)); } while (0)
#define mod ((float*)(F.ws + CTL_MOD_B))
#define XS ((bf16_t*)F.ob)
#define X ((float*)F.ob)
#define H ((bf16_t*)(F.ws + WS_H))
template <int l>
__device__ __forceinline__ void layer_phases(Frame& F, const XcdBarrier& bar, int& bx) {
        const float* modl = mod + l * 9 * 6144;
        if (l == 1) {
            { pg8::Gemm g{H, (const bf16_t*)(F.ws + WS_WQKV), 1024}; pg8::TileOrder S; S.init(128, 6, F.G, bx, 0, 192);
              pg8::EpiAttnQKV E{(bf16_t*)(F.ws + WS_AQ), (bf16_t*)(F.ws + WS_AK), (bf16_t*)(F.ws + WS_AV), (float*)(F.ob + OUT_NK), (float*)(F.ob + OUT_NV), (const float*)(F.ws + WS_TABA), (const float*)(F.ws + WS_NST) + MROWS, (const float*)(F.ws + WS_CB) + CB_QKV};
              pg8::gemm_phase<3>(F.lds, g, S, E);
#if PROBE_DUP == 9
              GRID_BAR(); pg8::gemm_phase<3>(F.lds, g, S, E);
#endif
#if PROBE_DUP == 16
              GRID_BAR(); { pg8::EpiNull E0{(float*)(F.ws + WS_TABA)}; pg8::gemm_phase<3>(F.lds, g, S, E0); }
#endif
            }
            GRID_BAR();
#ifndef NO_ATTN
            attn_phase(F);
#endif
            GRID_BAR();
#if PROBE_DUP == 3
            attn_phase(F, ATT_ABL | 2); GRID_BAR();
#endif
            { pg8::Gemm g{(const bf16_t*)(F.ws + WS_AO), (const bf16_t*)(F.ws + WS_WOA), 1024}; pg8::TileOrder S; S.init(128, 4, F.G, bx, 0, 192);
              pg8::EpiResidT<false> E{nullptr, nullptr, XS, XS, modl + 2 * 1024, H, inp(F, 11) + 1024, modl + 4 * 1024, (float*)(F.ws + WS_NST) + 2 * MROWS, 0};
              pg8::gemm_phase<3>(F.lds, g, S, E);
#if PROBE_DUP == 11
              GRID_BAR(); { pg8::EpiResidT<false> E2 = E; E2.dry = 1; pg8::gemm_phase<3>(F.lds, g, S, E2); }
#endif
            }
            GRID_BAR();
        }
        { pg8::Gemm g{H, (const bf16_t*)(F.ws + (l ? WS_WIN1 : WS_WIN0)), 1024}; pg8::TileOrder S; S.init(104, 22, F.G, bx, 1);
          pg8::EpiFfn E{(bf16_t*)(F.ws + WS_ACT), inp(F, 26) + (size_t)l * 3 * 5632, inp(F, 27) + (size_t)l * 5632, (LAS float*)(F.lds + XCH_OFF), (const float*)(F.ws + WS_NST) + (l ? 2 * MROWS : 0), (const float*)(F.ws + WS_CB) + (l ? CB_FFN1 : CB_FFN0), 0};
#ifndef NO_FFN
          pg8::gemm_phase<4>(F.lds, g, S, E, STG2);
#endif
#if PROBE_DUP == 7
          if (l == 0) { GRID_BAR(); pg8::gemm_phase<4>(F.lds, g, S, E); }
#endif
#if PROBE_DUP == 18
          if (l == 0) { GRID_BAR(); pg8::EpiFfn E2 = E; E2.dry = 1; pg8::gemm_phase<4>(F.lds, g, S, E2); }
#endif
#if PROBE_DUP == 13
          if (l == 0) { GRID_BAR(); pg8::EpiNull E0{(float*)(F.ws + WS_TABA)}; pg8::gemm_phase<4>(F.lds, g, S, E0); }
#endif
        }
        GRID_BAR();
        { pg8::Gemm g{(const bf16_t*)(F.ws + WS_ACT), (const bf16_t*)(F.ws + (l ? WS_WOUT1 : WS_WOUT0)), 2816}; pg8::TileOrder S; S.init(128, 4, F.G, bx, 0, 192);
          pg8::EpiResidT<false> E{nullptr, nullptr, XS, l ? H : XS, modl + 5 * 1024, l ? (bf16_t*)nullptr : H, inp(F, 10) + 1024, mod + 9 * 6144 + 1 * 1024, (float*)(F.ws + WS_NST) + MROWS, 0};
          pg8::gemm_phase<3>(F.lds, g, S, E);
#if PROBE_DUP == 8
          if (l == 0) { GRID_BAR(); pg8::EpiResidT<false> E2 = E; E2.dry = 1; pg8::gemm_phase<3>(F.lds, g, S, E2); }
#endif
#if PROBE_DUP == 17
          if (l == 0) { GRID_BAR(); pg8::EpiNull E0{(float*)(F.ws + WS_TABA)}; pg8::gemm_phase<3>(F.lds, g, S, E0); }
#endif
        }
        GRID_BAR();
    }

__global__ void __launch_bounds__(NWAVES * 64, 2) mega_fwd(Args args) {
    extern __shared__ __attribute__((aligned(16))) unsigned char lds_raw[];
    Frame F;
    F.lds = (LAS unsigned char*)lds_raw;
    volatile LAS unsigned* MISC = (volatile LAS unsigned*)(F.lds + MISC_OFF);
    F.G = gridDim.x; { const int bx = blockIdx.x; F.vcu = (F.G % 8 == 0) ? (bx % 8) * (F.G / 8) + bx / 8 : bx; }
    F.out = args.out; F.ws = args.ws; F.ob = (unsigned char*)args.out;
    for (int u = threadIdx.x; u < (LDS_BYTES - LDSCTL_OFF) / 4; u += NWAVES * 64) ((LAS unsigned*)(F.lds + LDSCTL_OFF))[u] = 0u;
    __syncthreads();
    if (threadIdx.x == 0) {
#pragma unroll
        for (int i = 0; i < 30; ++i) ((LAS unsigned long long*)(F.lds + INTAB_OFF))[i] = (unsigned long long)args.in[i];
    }
    __syncthreads();
    XcdBarrier bar = xcd_barrier_post((unsigned*)(F.ws + CTL_BAR_B), MISC + 8);
    int bx = (int)blockIdx.x;

#ifndef NO_P0
    p0_prologue(F);
#endif
    GRID_BAR();
#if PROBE_DUP == 1
    p0_prologue(F, true); GRID_BAR();
#endif
    modulate_rows(F, inp(F, 0), inp(F, 1), inp(F, 10), mod, 0, 1, (bf16_t*)(F.ob + OUT_H0)); GRID_BAR();
#if PROBE_DUP == 19
    modulate_rows(F, inp(F, 0), inp(F, 1), inp(F, 10), mod, 0, 1, (bf16_t*)(F.ob + OUT_H0)); GRID_BAR();
#endif
    { pg8::Gemm g{(const bf16_t*)(F.ob + OUT_H0), (const bf16_t*)(F.ob + OUT_W1T), 1024}; pg8::TileOrder S; S.init(96, 32, F.G, bx, 0);
      pg8::EpiRet E{(bf16_t*)(F.ws + WS_Q), (bf16_t*)(F.ws + WS_K), (bf16_t*)(F.ws + WS_V), (bf16_t*)(F.ws + WS_SGF), (bf16_t*)(F.ob + OUT_SGB), (const float*)(F.ws + WS_TABR), 0, 0};
      pg8::gemm_phase<4>(F.lds, g, S, E, STG1);
#if PROBE_DUP == 6
      GRID_BAR(); pg8::gemm_phase<4>(F.lds, g, S, E);
#endif
#if PROBE_DUP == 14
      GRID_BAR(); { pg8::EpiRet E2 = E; E2.dry = 1; pg8::gemm_phase<4>(F.lds, g, S, E2); }
#endif
#if PROBE_DUP == 15
      GRID_BAR(); { pg8::EpiRet E2 = E; E2.dry = 1; E2.nosilu = 1; pg8::gemm_phase<4>(F.lds, g, S, E2); }
#endif
#if PROBE_DUP == 12
      GRID_BAR(); { pg8::EpiNull E0{(float*)(F.ws + WS_TABA)}; pg8::gemm_phase<4>(F.lds, g, S, E0); }
#endif
    }
    GRID_BAR();
#if PROBE_DUP == 2
    retention_phase(F, true); GRID_BAR();
#endif
#ifndef NO_RET
    retention_phase(F);
#endif
    GRID_BAR();
    for (int rep_ = 0; rep_ < (PROBE_DUP == 4 ? 2 : 1); ++rep_)
    { combine_rows(F);
      PHASE_IDS();
      LAS float* scr = (LAS float*)(F.lds + wid * 16640); const int gw = F.vcu * NWAVES + wid, NGW = F.G * NWAVES;
      bf16_t* wqkv = (bf16_t*)(F.ws + WS_WQKV);
      const TrJob jobs[10] = { {inp(F, 17), 2048, 1024, (bf16_t*)(F.ws + WS_WO_RET), 0, 0, 512},
                               {inp(F, 25), 1024, 5632, (bf16_t*)(F.ws + WS_WIN0), 0, 3, 1408}, {inp(F, 25) + (size_t)1024 * 5632, 1024, 5632, (bf16_t*)(F.ws + WS_WIN1), 0, 3, 1408},
                               {inp(F, 28), 2816, 1024, (bf16_t*)(F.ws + WS_WOUT0), 0, 0, 704}, {inp(F, 28) + (size_t)2816 * 1024, 2816, 1024, (bf16_t*)(F.ws + WS_WOUT1), 0, 0, 704},
                               {inp(F, 20), 1024, 1024, wqkv, 0, 2, 256}, {inp(F, 21), 1024, 256, wqkv, 1024, 2, 64}, {inp(F, 22), 1024, 256, wqkv, 1280, 0, 64},
                               {inp(F, 23), 1024, 1024, (bf16_t*)(F.ws + WS_WOA), 0, 0, 256}, {nullptr, 0, 64, nullptr, 0, 0, 0} };
#ifndef NO_P4T
      run_transposes<10>(jobs, scr, gw, NGW, lane);
#endif
      bias_items(F, gw, NGW, lane);
    }
    GRID_BAR();
    { pg8::Gemm g{(const bf16_t*)(F.ws + WS_Y), (const bf16_t*)(F.ws + WS_WO_RET), 2048}; pg8::TileOrder S; S.init(128, 4, F.G, bx, 0, 192);
      pg8::EpiResidT<true> E{inp(F, 0), inp(F, 1), nullptr, XS, mod + 2 * 1024, H, inp(F, 11), mod + 4 * 1024, (float*)(F.ws + WS_NST), 0};
      pg8::gemm_phase<3>(F.lds, g, S, E);
#if PROBE_DUP == 10
      GRID_BAR(); { pg8::EpiResidT<true> E2 = E; E2.dry = 1; pg8::gemm_phase<3>(F.lds, g, S, E2); }
#endif
    }
    GRID_BAR();
    layer_phases<0>(F, bar, bx);
    layer_phases<1>(F, bar, bx);
    final_norm(F, H, X, inp(F, 29));
}

extern "C" void kernel_launch(void* const* d_in, const int* in_sizes, int n_in, void* d_out, int out_size, void* d_ws, size_t ws_size, hipStream_t stream) {
    static int grid = 0;
    if (grid == 0) {
        if (n_in != 30 || out_size != 62914560 || ws_size < WS_NEED) { fprintf(stderr, "kernel_launch: unexpected problem: n_in %d out %d ws %zu (need %zu)\n", n_in, out_size, ws_size, (size_t)WS_NEED); grid = -1; return; }
        int dev = 0, cus = 0, per_cu = 0;
        if (hipGetDevice(&dev) != hipSuccess || hipDeviceGetAttribute(&cus, hipDeviceAttributeMultiprocessorCount, dev) != hipSuccess) { grid = -1; return; }
        if (hipFuncSetAttribute((const void*)mega_fwd, hipFuncAttributeMaxDynamicSharedMemorySize, LDS_BYTES) != hipSuccess) { fprintf(stderr, "kernel_launch: hipFuncSetAttribute failed\n"); grid = -1; return; }
        if (hipOccupancyMaxActiveBlocksPerMultiprocessor(&per_cu, (const void*)mega_fwd, NWAVES * 64, LDS_BYTES) != hipSuccess || per_cu < 1) { fprintf(stderr, "kernel_launch: occupancy query says %d\n", per_cu); per_cu = 1; }
        (void)hipGetLastError();
        grid = cus;
    }
    if (grid < 0) return;
    (void)hipMemsetAsync((char*)d_ws, 0, CTL_BYTES, stream);
    Args a{};
    for (int i = 0; i < 30; ++i) a.in[i] = (const float*)d_in[i];
    a.out = (float*)d_out; a.ws = (unsigned char*)d_ws;
    void* kargs[] = {&a};
    hipError_t e = hipLaunchCooperativeKernel((const void*)mega_fwd, dim3(grid), dim3(NWAVES * 64), kargs, LDS_BYTES, stream);
    if (e != hipSuccess) { (void)hipGetLastError(); fprintf(stderr, "kernel_launch: cooperative launch failed (%s); plain launch\n", hipGetErrorString(e));
        hipLaunchKernelGGL(mega_fwd, dim3(grid), dim3(NWAVES * 64), LDS_BYTES, stream, a); }
}
```

```cpp
#include <hip/hip_runtime.h>
#include <cstdio>
#include <cstdint>
#ifndef PROBE_DUP
#define PROBE_DUP 0
#endif
#ifndef RET_ABL
#define RET_ABL 0
#endif
#ifndef ATT_ABL
#define ATT_ABL 0
#endif
#ifndef STG1
#define STG1 0
#endif
#ifndef STG2
#define STG2 0
#endif

#define LAS __attribute__((address_space(3)))
#define GAS __attribute__((address_space(1)))
typedef unsigned short bf16_t;
typedef short bf16x8 __attribute__((ext_vector_type(8)));
typedef short s16x4 __attribute__((ext_vector_type(4)));
typedef short v4i16_t __attribute__((ext_vector_type(4)));
typedef float f32x2 __attribute__((ext_vector_type(2)));
typedef float f32x4 __attribute__((ext_vector_type(4)));
typedef float f32x16 __attribute__((ext_vector_type(16)));
typedef unsigned u32x2 __attribute__((ext_vector_type(2)));
typedef unsigned u32x4 __attribute__((ext_vector_type(4)));
typedef __bf16 bf16x2_t __attribute__((ext_vector_type(2)));

constexpr int DM = 1024, NCTX = 8192, NLAT = 16384, MROWS = 24576, DFF = 2816;
constexpr float EPSV = 1e-6f;
constexpr float LOG2E = 1.4426950408889634f;

__device__ __forceinline__ unsigned cvtpk(float lo, float hi) { f32x2 v = {lo, hi}; bf16x2_t b = __builtin_convertvector(v, bf16x2_t); return __builtin_bit_cast(unsigned, b); }
__device__ __forceinline__ float bf2f(unsigned short x) { return __uint_as_float((unsigned)x << 16); }
__device__ __forceinline__ float bflo(unsigned w) { return __uint_as_float(w << 16); }
__device__ __forceinline__ float bfhi(unsigned w) { return __uint_as_float(w & 0xffff0000u); }
__device__ __forceinline__ float silu_f(float x) { return x * __builtin_amdgcn_rcpf(1.0f + __expf(-x)); }
__device__ __forceinline__ int crow(int r, int h) { return (r & 3) + 8 * (r >> 2) + 4 * h; }
#define PIN4(a, b, c, d) asm volatile("" : "+v"(a), "+v"(b), "+v"(c), "+v"(d))
#define PINV(x) asm volatile("" : "+v"(x))
#define FENCE() do { asm volatile("" ::: "memory"); __builtin_amdgcn_sched_barrier(0); } while (0)
#define MFMA32(a, b, c) __builtin_amdgcn_mfma_f32_32x32x16_bf16((a), (b), (c), 0, 0, 0)

namespace pg8 {
constexpr int BM = 256, BK = 64, HALF = 128, HTB = HALF * BK * 2, STAGE_BYTES = 8 * HTB, NXCD = 8, WGM = 8;
__host__ __device__ __forceinline__ int lds_byte(int r, int c) { const int st = (r >> 4) * 2 + (c >> 5), rr = r & 15, cc = c & 31, ob = rr * 64 + cc * 2; return st * 1024 + (ob ^ (((ob >> 9) & 1) << 5)); }
__host__ __device__ __forceinline__ void stage_rc(int b, int& R, int& C) { const int st = b / 1024, sb = b % 1024, swz = sb ^ (((sb >> 9) & 1) << 5); R = (st >> 1) * 16 + swz / 64; C = (st & 1) * 32 + (swz % 64) / 2; }
__host__ __device__ __forceinline__ int perm32(int rho) { const int n = rho >> 4, i = rho & 15; return 8 * (i >> 2) + 4 * n + (i & 3); }

struct Unit { int pm, pn, row0; };
struct Gemm { const bf16_t* A; const bf16_t* Bt; int K; };

__device__ __forceinline__ int ffn_row0(int pm) {
    if (pm < 32) return pm * 256;
    const int p = pm - 32, b = p / 9, k = p - 9 * b; const int s = 254 * k; return NCTX + b * 2048 + (s > 1792 ? 1792 : s);
}
struct TileOrder {
    int nM, nN, nwg, G, c, ffn, tm;
    __device__ __forceinline__ void init(int nM_, int nN_, int G_, int c_, int ffn_, int tm_ = 256) { nM = nM_; nN = nN_; nwg = nM * nN; G = G_; c = c_; ffn = ffn_; tm = tm_; }
    __device__ __forceinline__ bool next(int i, Unit& u) const {
        const long L = (long)i * G + c; if (L >= nwg) return false;
        int wgid = (int)L; { const int q = nwg / NXCD, r = nwg % NXCD, xcd = wgid % NXCD, off = wgid / NXCD; wgid = (xcd < r ? xcd * (q + 1) : r * (q + 1) + (xcd - r) * q) + off; }
        const int nig = WGM * nN, gid = wgid / nig, fm = gid * WGM, gsz = (nM - fm) < WGM ? (nM - fm) : WGM;
        u.pm = fm + ((wgid % nig) % gsz); u.pn = (wgid % nig) / gsz;
        u.row0 = ffn ? ffn_row0(u.pm) : u.pm * tm; return true;
    }
};


struct EpiRet {
    static constexpr bool PERM = true;
    bf16_t *q, *k, *v, *sgf, *sgb; const float* tab; int dry, nosilu;
    template <int MB>
    __device__ __forceinline__ void operator()(f32x4 (&acc)[2][2][MB][2], const Unit& u, int wr, int wc, int fr, int fq) const {
        const int pn = u.pn; const int rbase = u.row0 + wr * 64 + fr;
        if (pn < 8) {
            const bool isk = pn >= 4; bf16_t* dst = (isk ? k : q) + (pn & 3) * 256; const float sc = isk ? 0.0625f : 1.0f;
            const bool lat = u.row0 >= NCTX; const int i0 = 4 * (4 * wc + fq);
#define RET_TAB(k_, T_) do { const int r_ = rbase + ((k_) >> 2) * HALF + ((k_) & 3) * 16; const int s_ = (r_ - NCTX) & 2047; \
                const f32x4* ta_ = (const f32x4*)(tab + ((s_ >> 6) * 64 + i0) * 2); const f32x4* tb_ = (const f32x4*)(tab + ((s_ & 63) * 64 + i0) * 2); T_[0][0] = ta_[0]; T_[0][1] = ta_[1]; T_[1][0] = tb_[0]; T_[1][1] = tb_[1]; } while (0)
            f32x4 tc[2][2], tn[2][2];
            RET_TAB(0, tc);
#pragma unroll
            for (int kk = 0; kk < 8; ++kk) { const int ai = kk >> 2, m = kk & 3; const int r = rbase + ai * HALF + m * 16;
                    if (kk < 7) RET_TAB(kk + 1, tn);
                    f32x4 av[2][2] = {{acc[ai][0][m][0], acc[ai][0][m][1]}, {acc[ai][1][m][0], acc[ai][1][m][1]}}; PIN4(av[0][0], av[0][1], av[1][0], av[1][1]);
#pragma unroll
                    for (int bj = 0; bj < 2; ++bj) {
                        f32x4 x1 = av[bj][0] * sc, x2 = av[bj][1] * sc, o1 = x1, o2 = x2;
                        if (lat) { const f32x4 t0 = tc[bj][0], t1 = tc[bj][1];
                            const f32x4 cs = {t0[0], t0[2], t1[0], t1[2]}, sn = {t0[1], t0[3], t1[1], t1[3]};
                            o1 = x1 * cs - x2 * sn; o2 = x1 * sn + x2 * cs; }
                        bf16_t* p = dst + (size_t)r * 1024 + 128 * bj + i0;
                        u32x2 w1 = {cvtpk(o1[0], o1[1]), cvtpk(o1[2], o1[3])}, w2 = {cvtpk(o2[0], o2[1]), cvtpk(o2[2], o2[3])};
                        if (!dry) { *(u32x2*)p = w1; *(u32x2*)(p + 64) = w2; } else asm volatile("" :: "v"(w1), "v"(w2)); }
                    asm volatile("" ::: "memory");
#pragma unroll
                    for (int bj = 0; bj < 2; ++bj) { tc[bj][0] = tn[bj][0]; tc[bj][1] = tn[bj][1]; } }
#undef RET_TAB
        } else if (pn < 16) { store_plain(acc, v, (pn - 8) * 256, false, rbase, wc, fq); }
        else if (pn < 24) { store_plain(acc, sgf, (pn - 16) * 256, true, rbase, wc, fq); }
        else { store_plain(acc, sgb, (pn - 24) * 256, true, rbase, wc, fq); }
    }
    __device__ __forceinline__ void store_plain(const f32x4 (&acc)[2][2][4][2], bf16_t* dst, int col0, bool act, int rbase, int wc, int fq) const {
        const int col = col0 + wc * 32 + 8 * fq;
#pragma unroll
        for (int ai = 0; ai < 2; ++ai)
#pragma unroll
            for (int m = 0; m < 4; ++m) { bf16_t* rowp = dst + (size_t)(rbase + ai * HALF + m * 16) * 2048 + col;
                f32x4 av[2][2] = {{acc[ai][0][m][0], acc[ai][0][m][1]}, {acc[ai][1][m][0], acc[ai][1][m][1]}}; PIN4(av[0][0], av[0][1], av[1][0], av[1][1]);
#pragma unroll
                for (int bj = 0; bj < 2; ++bj) { f32x4 v0 = av[bj][0], v1 = av[bj][1];
                    if (act && !nosilu) { for (int j = 0; j < 4; ++j) { v0[j] = silu_f(v0[j]); v1[j] = silu_f(v1[j]); } }
                    u32x4 w; w.x = cvtpk(v0[0], v0[1]); w.y = cvtpk(v0[2], v0[3]); w.z = cvtpk(v1[0], v1[1]); w.w = cvtpk(v1[2], v1[3]);
                    if (!dry) *(u32x4*)(rowp + bj * HALF) = w; else asm volatile("" :: "v"(w)); }
                asm volatile("" ::: "memory"); }
    }
};

struct EpiNull { static constexpr bool PERM = true; float* sink;
    template <int MB> __device__ __forceinline__ void operator()(f32x4 (&acc)[2][2][MB][2], const Unit& u, int wr, int wc, int fr, int fq) const {
        f32x4 t = acc[0][0][0][0];
#pragma unroll
        for (int a = 0; a < 2; ++a)
#pragma unroll
            for (int b = 0; b < 2; ++b)
#pragma unroll
                for (int m = 0; m < MB; ++m) { t += acc[a][b][m][0]; t += acc[a][b][m][1]; }
        if (t[0] == 12345.678f) sink[0] = t[1] + t[2] + t[3]; } };

template <bool INF32>
struct EpiResidT {
    static constexpr bool PERM = true;
    const float* xa; const float* xb; const bf16_t* xs; bf16_t* xo; const float* gate;
    bf16_t* xt; const float* gn; const float* scn; float* nst; int dry;
    template <int MB>
    __device__ __forceinline__ void operator()(f32x4 (&acc)[2][2][MB][2], const Unit& u, int wr, int wc, int fr, int fq) const {
        const int col0 = u.pn * BM + wc * 32 + 8 * fq;
        const int mb0 = u.row0 < NCTX ? 8 : ((u.row0 - NCTX) >> 11);
        f32x4 gv0[2][2], av0[2][2];
#pragma unroll
        for (int bj = 0; bj < 2; ++bj)
#pragma unroll
            for (int n = 0; n < 2; ++n) { const int c = col0 + bj * HALF + n * 4; gv0[bj][n] = *(const f32x4*)(gate + mb0 * 6144 + c);
                av0[bj][n] = xt ? *(const f32x4*)(gn + c) * (1.0f + *(const f32x4*)(scn + mb0 * 6144 + c)) : (f32x4){0.f, 0.f, 0.f, 0.f}; }
        const int rb = u.row0 + wr * 16 * MB + fr;
        f32x4 xc[2][2], xn2[2][2];
#define RES_LOAD(k_, X_) do { const int r_ = rb + ((k_) / MB) * 32 * MB + ((k_) % MB) * 16; \
            if (INF32) { const float* p_ = (r_ < NCTX ? xa + (size_t)r_ * 1024 : xb + (size_t)(r_ - NCTX) * 1024) + col0; \
                _Pragma("unroll") for (int bj = 0; bj < 2; ++bj) { X_[bj][0] = *(const f32x4*)(p_ + bj * HALF); X_[bj][1] = *(const f32x4*)(p_ + bj * HALF + 4); } } \
            else { const bf16_t* p_ = xs + (size_t)r_ * 1024 + col0; \
                _Pragma("unroll") for (int bj = 0; bj < 2; ++bj) { const u32x4 w_ = *(const u32x4*)(p_ + bj * HALF); X_[bj][0] = (f32x4){bflo(w_.x), bfhi(w_.x), bflo(w_.y), bfhi(w_.y)}; X_[bj][1] = (f32x4){bflo(w_.z), bfhi(w_.z), bflo(w_.w), bfhi(w_.w)}; } } } while (0)
        RES_LOAD(0, xc);
#pragma unroll
        for (int k = 0; k < 2 * MB; ++k) { const int ai = k / MB, m = k % MB; const int r = rb + ai * 32 * MB + m * 16;
            if (k + 1 < 2 * MB) RES_LOAD(k + 1, xn2);
            const int mb = r < NCTX ? 8 : ((r - NCTX) >> 11);
            f32x4 av[2][2] = {{acc[ai][0][m][0], acc[ai][0][m][1]}, {acc[ai][1][m][0], acc[ai][1][m][1]}}; PIN4(av[0][0], av[0][1], av[1][0], av[1][1]);
            float ss = 0.f;
#pragma unroll
            for (int bj = 0; bj < 2; ++bj) { f32x4 xv[2], yv[2];
#pragma unroll
                for (int n = 0; n < 2; ++n) { const int c = col0 + bj * HALF + n * 4; f32x4 gv = gv0[bj][n], a4 = av0[bj][n];
                    if (mb != mb0) { gv = *(const f32x4*)(gate + mb * 6144 + c); if (xt) a4 = *(const f32x4*)(gn + c) * (1.0f + *(const f32x4*)(scn + mb * 6144 + c)); }
                    xv[n] = xc[bj][n] + gv * av[bj][n]; yv[n] = xv[n] * a4;
                    ss += (xv[n][0] * xv[n][0] + xv[n][1] * xv[n][1]) + (xv[n][2] * xv[n][2] + xv[n][3] * xv[n][3]); }
                u32x4 wx; wx.x = cvtpk(xv[0][0], xv[0][1]); wx.y = cvtpk(xv[0][2], xv[0][3]); wx.z = cvtpk(xv[1][0], xv[1][1]); wx.w = cvtpk(xv[1][2], xv[1][3]);
                if (!dry) *(u32x4*)(xo + (size_t)r * 1024 + col0 + bj * HALF) = wx; else asm volatile("" :: "v"(wx));
                if (xt) { u32x4 wy; wy.x = cvtpk(yv[0][0], yv[0][1]); wy.y = cvtpk(yv[0][2], yv[0][3]); wy.z = cvtpk(yv[1][0], yv[1][1]); wy.w = cvtpk(yv[1][2], yv[1][3]);
                    if (!dry) *(u32x4*)(xt + (size_t)r * 1024 + col0 + bj * HALF) = wy; else asm volatile("" :: "v"(wy)); } }
            if (xt) { ss += __shfl_xor(ss, 16); ss += __shfl_xor(ss, 32); if (fq == 0 && !dry) atomicAdd(nst + r, ss); else asm volatile("" :: "v"(ss)); }
            asm volatile("" ::: "memory");
#pragma unroll
            for (int bj = 0; bj < 2; ++bj)
#pragma unroll
                for (int n = 0; n < 2; ++n) xc[bj][n] = xn2[bj][n];
        }
#undef RES_LOAD
    }
};

struct EpiAttnQKV {
    static constexpr bool PERM = true;
    bf16_t *q, *k, *v; float *ok, *ov; const float* tab;
    const float* nst; const float* cb;
    template <int MB>
    __device__ __forceinline__ void operator()(f32x4 (&acc)[2][2][MB][2], const Unit& u, int wr, int wc, int fr, int fq) const {
        const int pn = u.pn; const int rbase = u.row0 + wr * 16 * MB + fr;
        float rsn[2 * MB];
#pragma unroll
        for (int k = 0; k < 2 * MB; ++k) rsn[k] = nst[rbase + (k / MB) * 32 * MB + (k % MB) * 16];
        if (pn < 5) {
            const bool isk = pn == 4; const float sc = isk ? 1.0f : 0.125f * LOG2E; const int half = wc & 1, i0 = 4 * fq;
            const int mb0 = u.row0 < NCTX ? 8 : ((u.row0 - NCTX) >> 11);
            const int cboff = (isk ? 1024 : pn * 256) + (wc >> 1) * 64 + 32 * half + i0;
            f32x4 cb0[2][2];
#pragma unroll
            for (int bj = 0; bj < 2; ++bj) { cb0[bj][0] = *(const f32x4*)(cb + mb0 * 1536 + cboff + 128 * bj); cb0[bj][1] = *(const f32x4*)(cb + mb0 * 1536 + cboff + 128 * bj + 16); }
#define QKV_TAB(k_, T0_, T1_) do { const int r_ = rbase + ((k_) / MB) * 32 * MB + ((k_) % MB) * 16; const int s_ = (r_ - NCTX) & 2047; const int pos_ = half ? (s_ & 63) : (s_ >> 6); \
                const f32x4* tp_ = (const f32x4*)(tab + (pos_ * 16 + i0) * 2); T0_ = tp_[0]; T1_ = tp_[1]; } while (0)
            f32x4 tc0, tc1, tn0, tn1;
            QKV_TAB(0, tc0, tc1);
#pragma unroll
            for (int kk = 0; kk < 2 * MB; ++kk) { const int ai = kk / MB, m = kk % MB; const int r = rbase + ai * 32 * MB + m * 16; const bool lat = r >= NCTX;
                    if (kk + 1 < 2 * MB) QKV_TAB(kk + 1, tn0, tn1);
                    f32x4 av[2][2] = {{acc[ai][0][m][0], acc[ai][0][m][1]}, {acc[ai][1][m][0], acc[ai][1][m][1]}}; PIN4(av[0][0], av[0][1], av[1][0], av[1][1]);
                    { const float rstd = 1.0f / sqrtf(rsn[ai * MB + m] * (1.0f / 1024.0f) + EPSV); const int mb = r < NCTX ? 8 : ((r - NCTX) >> 11);
#pragma unroll
                      for (int bj = 0; bj < 2; ++bj) { f32x4 c0 = cb0[bj][0], c1 = cb0[bj][1];
                          if (mb != mb0) { c0 = *(const f32x4*)(cb + mb * 1536 + cboff + 128 * bj); c1 = *(const f32x4*)(cb + mb * 1536 + cboff + 128 * bj + 16); }
                          av[bj][0] = av[bj][0] * rstd + c0; av[bj][1] = av[bj][1] * rstd + c1; } }
                    f32x4 cs = {1.f, 1.f, 1.f, 1.f}, sn = {0.f, 0.f, 0.f, 0.f};
                    if (lat) { cs = (f32x4){tc0[0], tc0[2], tc1[0], tc1[2]}; sn = (f32x4){tc0[1], tc0[3], tc1[1], tc1[3]}; }
#pragma unroll
                    for (int bj = 0; bj < 2; ++bj) { const int hh = 2 * bj + (wc >> 1);
                        const f32x4 x1 = av[bj][0], x2 = av[bj][1];
                        const f32x4 o1 = (x1 * cs - x2 * sn) * sc, o2 = (x1 * sn + x2 * cs) * sc;
                        const int t1c = 32 * half + i0;
                        bf16_t* p = isk ? k + (size_t)r * 256 + hh * 64 + t1c : q + (size_t)r * 1024 + (pn * 4 + hh) * 64 + t1c;
                        u32x2 w1 = {cvtpk(o1[0], o1[1]), cvtpk(o1[2], o1[3])}, w2 = {cvtpk(o2[0], o2[1]), cvtpk(o2[2], o2[3])};
                        *(u32x2*)p = w1; *(u32x2*)(p + 16) = w2;
                        if (isk && !lat) { float* o = ok + (size_t)r * 256 + hh * 64 + t1c; *(f32x4*)o = x1; *(f32x4*)(o + 16) = x2; } }
                    asm volatile("" ::: "memory"); tc0 = tn0; tc1 = tn1; }
#undef QKV_TAB
        } else {
            const int col = wc * 32 + 8 * fq;
#pragma unroll
            for (int ai = 0; ai < 2; ++ai)
#pragma unroll
                for (int m = 0; m < MB; ++m) { const int r = rbase + ai * 32 * MB + m * 16; const bool lat = r >= NCTX;
                    f32x4 av[2][2] = {{acc[ai][0][m][0], acc[ai][0][m][1]}, {acc[ai][1][m][0], acc[ai][1][m][1]}}; PIN4(av[0][0], av[0][1], av[1][0], av[1][1]);
                    { const float rstd = 1.0f / sqrtf(rsn[ai * MB + m] * (1.0f / 1024.0f) + EPSV); const int mb = r < NCTX ? 8 : ((r - NCTX) >> 11);
#pragma unroll
                      for (int bj = 0; bj < 2; ++bj) { const float* cp = cb + mb * 1536 + 1280 + col + bj * HALF;
                          av[bj][0] = av[bj][0] * rstd + *(const f32x4*)cp; av[bj][1] = av[bj][1] * rstd + *(const f32x4*)(cp + 4); } }
#pragma unroll
                    for (int bj = 0; bj < 2; ++bj) { const f32x4 v0 = av[bj][0], v1 = av[bj][1];
                        u32x4 w; w.x = cvtpk(v0[0], v0[1]); w.y = cvtpk(v0[2], v0[3]); w.z = cvtpk(v1[0], v1[1]); w.w = cvtpk(v1[2], v1[3]);
                        *(u32x4*)(v + (size_t)r * 256 + col + bj * HALF) = w;
                        if (!lat) { float* o = ov + (size_t)r * 256 + col + bj * HALF; *(f32x4*)o = v0; *(f32x4*)(o + 4) = v1; } }
                    asm volatile("" ::: "memory"); }
        }
    }
};

struct EpiFfn {
    static constexpr bool PERM = true;
    bf16_t* act; const float* cw; const float* cb; LAS float* xch;
    const float* nst; const float* cbias; int dry;
    template <int MB>
    __device__ __forceinline__ void operator()(f32x4 (&acc)[2][2][MB][2], const Unit& u, int wr, int wc, int fr, int fq) const {
        const int lane = 16 * fq + fr; (void)lane;
        f32x4 cwv[2][8];
#define FFN_LDW(bj_) do { const int c0_ = u.pn * 128 + 64 * (bj_) + 16 * wc + 4 * fq; \
            cwv[bj_][0] = *(const f32x4*)(cw + c0_); cwv[bj_][1] = *(const f32x4*)(cw + 5632 + c0_); cwv[bj_][2] = *(const f32x4*)(cw + 2 * 5632 + c0_); cwv[bj_][3] = *(const f32x4*)(cb + c0_); \
            cwv[bj_][4] = *(const f32x4*)(cw + DFF + c0_); cwv[bj_][5] = *(const f32x4*)(cw + 5632 + DFF + c0_); cwv[bj_][6] = *(const f32x4*)(cw + 2 * 5632 + DFF + c0_); cwv[bj_][7] = *(const f32x4*)(cb + DFF + c0_); } while (0)
        FFN_LDW(0);
        { const int mb = u.row0 < NCTX ? 8 : ((u.row0 - NCTX) >> 11);
          f32x4 cu[2], cg[2];
#pragma unroll
          for (int bj = 0; bj < 2; ++bj) { const int c0 = u.pn * 128 + 64 * bj + 16 * wc + 4 * fq; cu[bj] = *(const f32x4*)(cbias + mb * 5632 + c0); cg[bj] = *(const f32x4*)(cbias + mb * 5632 + DFF + c0); }
          float rs8[8];
#pragma unroll
          for (int k = 0; k < 8; ++k) rs8[k] = nst[u.row0 + (k >> 2) * HALF + wr * 64 + (k & 3) * 16 + fr];
#pragma unroll
          for (int ai = 0; ai < 2; ++ai)
#pragma unroll
              for (int m = 0; m < 4; ++m) { float rstd = 1.0f / sqrtf(rs8[ai * 4 + m] * (1.0f / 1024.0f) + EPSV);
                  PIN4(acc[ai][0][m][0], acc[ai][0][m][1], acc[ai][1][m][0], acc[ai][1][m][1]);
#pragma unroll
                  for (int bj = 0; bj < 2; ++bj) { acc[ai][bj][m][0] = acc[ai][bj][m][0] * rstd + cu[bj]; acc[ai][bj][m][1] = acc[ai][bj][m][1] * rstd + cg[bj]; }
                  PIN4(acc[ai][0][m][0], acc[ai][0][m][1], acc[ai][1][m][0], acc[ai][1][m][1]); asm volatile("" ::: "memory"); } }
        int lo = 0, hi = 256;
        if (u.pm >= 32) { const int k = (u.pm - 32) % 9; if (k == 0) { hi = 255; } else if (k < 8) { lo = 1; hi = 255; } else { lo = 241; hi = 256; } }
#pragma unroll
        for (int ai = 0; ai < 2; ++ai)
#pragma unroll
            for (int bj = 0; bj < 2; ++bj) {
                if (fr == 0) { LAS f32x4* p = (LAS f32x4*)xch + ((((ai * 2 + wr) * 2 + 0) * 4 + wc) * 4 + fq) * 4 + bj * 2; p[0] = acc[ai][bj][0][0]; p[1] = acc[ai][bj][0][1]; }
                if (fr == 15) { LAS f32x4* p = (LAS f32x4*)xch + ((((ai * 2 + wr) * 2 + 1) * 4 + wc) * 4 + fq) * 4 + bj * 2; p[0] = acc[ai][bj][3][0]; p[1] = acc[ai][bj][3][1]; }
            }
        asm volatile("s_waitcnt lgkmcnt(0)" ::: "memory"); __builtin_amdgcn_s_barrier(); asm volatile("" ::: "memory");
        FFN_LDW(1);
#pragma unroll
        for (int bj = 0; bj < 2; ++bj) {
            const int c0 = u.pn * 128 + 64 * bj + 16 * wc + 4 * fq;
            const f32x4 wu0 = cwv[bj][0], wu1 = cwv[bj][1], wu2 = cwv[bj][2], bu = cwv[bj][3], wg0 = cwv[bj][4], wg1 = cwv[bj][5], wg2 = cwv[bj][6], bg = cwv[bj][7];
#pragma unroll
            for (int ai = 0; ai < 2; ++ai) {
#pragma unroll
                for (int m = 0; m < 4; ++m) {
                    f32x4 uc = acc[ai][bj][m][0], gc = acc[ai][bj][m][1];
                    f32x4 sp_u = (m > 0 && fr == 15) ? acc[ai][bj][m > 0 ? m - 1 : 0][0] : uc, sp_g = (m > 0 && fr == 15) ? acc[ai][bj][m > 0 ? m - 1 : 0][1] : gc;
                    f32x4 sn_u = (m < 3 && fr == 0) ? acc[ai][bj][m < 3 ? m + 1 : 3][0] : uc, sn_g = (m < 3 && fr == 0) ? acc[ai][bj][m < 3 ? m + 1 : 3][1] : gc;
                    PIN4(uc, gc, sp_u, sp_g); PIN4(sn_u, sn_g, uc, gc);
                    f32x4 up, gp, un, gn;
#pragma unroll
                    for (int j = 0; j < 4; ++j) {
                        up[j] = __int_as_float(__builtin_amdgcn_update_dpp(0, __float_as_int(sp_u[j]), 0x121, 0xf, 0xf, false)); gp[j] = __int_as_float(__builtin_amdgcn_update_dpp(0, __float_as_int(sp_g[j]), 0x121, 0xf, 0xf, false));
                        un[j] = __int_as_float(__builtin_amdgcn_update_dpp(0, __float_as_int(sn_u[j]), 0x12F, 0xf, 0xf, false)); gn[j] = __int_as_float(__builtin_amdgcn_update_dpp(0, __float_as_int(sn_g[j]), 0x12F, 0xf, 0xf, false)); }
                    if (m == 0) {
                        f32x4 pu = {0.f, 0.f, 0.f, 0.f}, pg = pu; int pai = ai, pwr = wr - 1; if (pwr < 0) { pwr = 1; pai = ai - 1; }
                        if (pai >= 0) { const LAS f32x4* p = (const LAS f32x4*)xch + ((((pai * 2 + pwr) * 2 + 1) * 4 + wc) * 4 + fq) * 4 + bj * 2; pu = p[0]; pg = p[1]; }
                        if (fr == 0) { up = pu; gp = pg; } }
                    if (m == 3) {
                        f32x4 nu = {0.f, 0.f, 0.f, 0.f}, ng = nu; int nai = ai, nwr = wr + 1; if (nwr > 1) { nwr = 0; nai = ai + 1; }
                        if (nai < 2) { const LAS f32x4* p = (const LAS f32x4*)xch + ((((nai * 2 + nwr) * 2 + 0) * 4 + wc) * 4 + fq) * 4 + bj * 2; nu = p[0]; ng = p[1]; }
                        if (fr == 15) { un = nu; gn = ng; } }
                    const f32x4 uu = wu0 * up + wu1 * uc + wu2 * un + bu;
                    const f32x4 gg = wg0 * gp + wg1 * gc + wg2 * gn + bg;
                    const int lr = ai * HALF + wr * 64 + m * 16 + fr;
                    if (lr >= lo && lr < hi) { u32x2 w = {cvtpk(silu_f(gg[0]) * uu[0], silu_f(gg[1]) * uu[1]), cvtpk(silu_f(gg[2]) * uu[2], silu_f(gg[3]) * uu[3])};
                        if (!dry) *(u32x2*)(act + (size_t)(u.row0 + lr) * DFF + c0) = w; else asm volatile("" :: "v"(w)); }
                    asm volatile("" ::: "memory");
                }
            }
        }
        asm volatile("s_waitcnt lgkmcnt(0)" ::: "memory"); __builtin_amdgcn_s_barrier(); asm volatile("" ::: "memory");
#undef FFN_LDW
    }
};

template <int MB, class Epi, class Sched>
__device__ __forceinline__ void gemm_phase(LAS unsigned char* lds, const Gemm g, const Sched& S, const Epi& E, int stagger = 0) {
    if (stagger) { const unsigned long long t0 = __builtin_amdgcn_s_memrealtime(); const unsigned long long dl = (unsigned long long)((S.c >> 3) & 7) * (unsigned)stagger; while (__builtin_amdgcn_s_memrealtime() - t0 < dl) __builtin_amdgcn_s_sleep(4); }
    int tid_ = threadIdx.x; asm volatile("" : "+v"(tid_));
    const int tid = tid_, wid = __builtin_amdgcn_readfirstlane(tid >> 6), lane = tid & 63, wr = wid >> 2, wc = wid & 3, fr = lane & 15, fq = lane >> 4;
    const int K = g.K, nt = K / BK;
    unsigned voffA[2], voffB[2];
#pragma unroll
    for (int i = 0; i < 2; ++i) { int R, C; stage_rc(tid * 16 + i * 8192, R, C); const int Rb = Epi::PERM ? ((R & ~31) + perm32(R & 31)) : R;
        voffA[i] = (unsigned)(R * K + C) * 2u; voffB[i] = (unsigned)(Rb * K + C) * 2u; }
    const size_t kstep = (size_t)(BK * 2);
    const size_t hstep = (size_t)HALF * K * 2;
    const size_t hstepA = (size_t)(32 * MB) * K * 2;
    const size_t tstep = 2 * hstep;
    const size_t rstep = (size_t)K * 2;
    const unsigned ldsw = (unsigned)wid * 1024u;
    const int aoff = lds_byte(wr * 16 * MB + fr, fq * 8), boff = lds_byte(wc * 32 + fr, fq * 8);
#define PG8_SA(b, h) (((b) * 2 + (h)) * HTB)
#define PG8_SB(b, h) ((4 + (b) * 2 + (h)) * HTB)
#define PG8_STAGE(bufoff, gbase, voff) do { _Pragma("unroll") for (int _i = 0; _i < 2; ++_i) \
        __builtin_amdgcn_global_load_lds((const unsigned*)((const char*)(gbase) + (voff)[_i]), (LAS unsigned*)(lds + (bufoff) + ldsw + _i * 8192), 16, 0, 0); } while (0)
#define PG8_LDA(dst, b, h) do { _Pragma("unroll") for (int m = 0; m < MB; ++m) _Pragma("unroll") for (int k = 0; k < 2; ++k) dst[m][k] = *(const LAS bf16x8*)(lds + PG8_SA(b, h) + aoff + m * 2048 + k * 1024); } while (0)
#define PG8_LDB(dst, b, h) do { _Pragma("unroll") for (int n = 0; n < 2; ++n) _Pragma("unroll") for (int k = 0; k < 2; ++k) dst[n][k] = *(const LAS bf16x8*)(lds + PG8_SB(b, h) + boff + n * 2048 + k * 1024); } while (0)
#define PG8_MMA(ai, bj, At, Bt) do { __builtin_amdgcn_s_setprio(1); _Pragma("unroll") for (int m = 0; m < MB; ++m) _Pragma("unroll") for (int n = 0; n < 2; ++n) _Pragma("unroll") for (int k = 0; k < 2; ++k) \
        acc[ai][bj][m][n] = __builtin_amdgcn_mfma_f32_16x16x32_bf16(Bt[n][k], At[m][k], acc[ai][bj][m][n], 0, 0, 0); __builtin_amdgcn_s_setprio(0); } while (0)
#define PG8_WAIT_V(n) asm volatile("s_waitcnt vmcnt(" #n ")" ::: "memory")
#define PG8_WAIT_L(n) asm volatile("s_waitcnt lgkmcnt(" #n ")" ::: "memory")
#define PG8_BAR __builtin_amdgcn_s_barrier()
#define PG8_SCHED __builtin_amdgcn_sched_barrier(0)
    Unit cur, nxt; int ui = 0;
    if (!S.next(0, cur)) return;
    f32x4 acc[2][2][MB][2];
#pragma unroll
    for (int a = 0; a < 2; ++a)
#pragma unroll
        for (int b = 0; b < 2; ++b)
#pragma unroll
            for (int m = 0; m < MB; ++m)
#pragma unroll
                for (int n = 0; n < 2; ++n) acc[a][b][m][n] = (f32x4){0.f, 0.f, 0.f, 0.f};
    bf16x8 At[MB][2], B0[2][2], B1[2][2];
    const char* cA = (const char*)g.A + (size_t)cur.row0 * rstep; const char* cB = (const char*)g.Bt + (size_t)cur.pn * tstep;
    PG8_STAGE(PG8_SB(0, 0), cB, voffB); PG8_STAGE(PG8_SB(0, 1), cB + hstep, voffB); PG8_STAGE(PG8_SA(0, 0), cA, voffA); PG8_STAGE(PG8_SA(0, 1), cA + hstepA, voffA);
    if (wr == 1) PG8_BAR;
    PG8_WAIT_V(2); PG8_BAR;
    PG8_STAGE(PG8_SB(1, 0), cB + kstep, voffB); PG8_STAGE(PG8_SA(1, 0), cA + kstep, voffA); PG8_STAGE(PG8_SB(1, 1), cB + hstep + kstep, voffB);
    PG8_WAIT_V(6); PG8_BAR;
    for (;;) {
        const bool has_next = S.next(ui + 1, nxt);
        const char* nA = has_next ? (const char*)g.A + (size_t)nxt.row0 * rstep : cA; const char* nB = has_next ? (const char*)g.Bt + (size_t)nxt.pn * tstep : cB;
        for (int t = 0; t < nt; t += 2) {
            const bool last = (t == nt - 2);
            const char* a1 = cA + (size_t)(t + 1) * kstep;
            const char* a2 = last ? nA : cA + (size_t)(t + 2) * kstep; const char* b2 = last ? nB : cB + (size_t)(t + 2) * kstep;
            const char* a3 = a2 + kstep; const char* b3 = b2 + kstep;
            PG8_LDB(B0, 0, 0); PG8_LDB(B1, 0, 1); PG8_SCHED; PG8_LDA(At, 0, 0); PG8_STAGE(PG8_SA(1, 1), a1 + hstepA, voffA);
            PG8_WAIT_V(8); PG8_WAIT_L(0); PG8_BAR; PG8_MMA(0, 0, At, B0); PG8_MMA(0, 1, At, B1); PG8_BAR; PG8_SCHED;
            PG8_LDA(At, 0, 1); PG8_STAGE(PG8_SB(0, 0), b2, voffB); PG8_STAGE(PG8_SB(0, 1), b2 + hstep, voffB); PG8_STAGE(PG8_SA(0, 0), a2, voffA);
            PG8_WAIT_V(8); PG8_WAIT_L(0); PG8_BAR; PG8_MMA(1, 0, At, B0); PG8_MMA(1, 1, At, B1); PG8_BAR; PG8_SCHED;
            PG8_LDB(B0, 1, 0); PG8_LDB(B1, 1, 1); PG8_SCHED; PG8_LDA(At, 1, 0); PG8_STAGE(PG8_SA(0, 1), a2 + hstepA, voffA);
            PG8_WAIT_V(8); PG8_WAIT_L(0); PG8_BAR; PG8_MMA(0, 0, At, B0); PG8_MMA(0, 1, At, B1); PG8_BAR; PG8_SCHED;
            PG8_LDA(At, 1, 1); PG8_STAGE(PG8_SB(1, 0), b3, voffB); PG8_STAGE(PG8_SB(1, 1), b3 + hstep, voffB); PG8_STAGE(PG8_SA(1, 0), a3, voffA);
            PG8_WAIT_V(8); PG8_WAIT_L(0); PG8_BAR; PG8_MMA(1, 0, At, B0); PG8_MMA(1, 1, At, B1); PG8_BAR; PG8_SCHED;
        }
        if (wr == 0) PG8_BAR;
        { int l2 = threadIdx.x & 63; asm volatile("" : "+v"(l2)); E.template operator()<MB>(acc, cur, wr, wc, l2 & 15, l2 >> 4); }
        if (!has_next) break;
#pragma unroll
        for (int a = 0; a < 2; ++a)
#pragma unroll
            for (int b = 0; b < 2; ++b)
#pragma unroll
                for (int m = 0; m < MB; ++m)
#pragma unroll
                    for (int n = 0; n < 2; ++n) acc[a][b][m][n] = (f32x4){0.f, 0.f, 0.f, 0.f};
        cur = nxt; cA = nA; cB = nB; ++ui;
        if (wr == 1) PG8_BAR;
    }
    PG8_WAIT_V(0);
    PG8_BAR;
#undef PG8_SA
#undef PG8_SB
#undef PG8_STAGE
#undef PG8_LDA
#undef PG8_LDB
#undef PG8_MMA
#undef PG8_WAIT_V
#undef PG8_WAIT_L
#undef PG8_BAR
#undef PG8_SCHED
}
}

constexpr int NWAVES = 8;
constexpr size_t MiB = 1u << 20;
constexpr size_t CTL_BYTES = 2 * MiB;
constexpr size_t CTL_BAR_B = 16384, CTL_MOD_B = 65536, CTL_STATS_B = 524288;
constexpr size_t WS_TABR = 2 * MiB, WS_TABA = 2 * MiB + 65536;
constexpr size_t WS_CK = 3 * MiB, WS_CV = 4 * MiB;
constexpr size_t WS_Q = 8 * MiB, WS_K = 56 * MiB, WS_V = 104 * MiB, WS_SGF = 200 * MiB, WS_NEED = 296 * MiB;
constexpr size_t WS_Y = 200 * MiB;
constexpr size_t WS_NST = 5 * MiB;
constexpr size_t WS_CB = 5 * MiB + 512 * 1024;
constexpr int CB_FFN0 = 0, CB_FFN1 = 9 * 5632, CB_QKV = 2 * 9 * 5632, CB_TOTAL = 2 * 9 * 5632 + 9 * 1536;
constexpr size_t WS_WO_RET = 104 * MiB, WS_WIN0 = 108 * MiB, WS_WIN1 = 119 * MiB, WS_WOUT0 = 130 * MiB, WS_WOUT1 = 135 * MiB + 512 * 1024,
                 WS_WQKV = 141 * MiB, WS_WOA = 144 * MiB;
constexpr size_t WS_H = 8 * MiB;
constexpr size_t WS_ACT = 160 * MiB;
constexpr size_t WS_AQ = 56 * MiB, WS_AK = 146 * MiB, WS_AV = 158 * MiB, WS_AO = 200 * MiB;
constexpr size_t OUT_SGB = 0;
constexpr size_t OUT_H0 = 96 * MiB, OUT_W1T = 144 * MiB;
constexpr size_t OUT_SF = (size_t)25165824 * 4, OUT_SB = (size_t)41943040 * 4, OUT_NK = (size_t)58720256 * 4, OUT_NV = (size_t)60817408 * 4;
constexpr int RING_BYTES = 131072, XCH_OFF = 131072, LDSCTL_OFF = 147456, MISC_OFF = LDSCTL_OFF + 320, INTAB_OFF = LDSCTL_OFF + 512, LDS_BYTES = 151552;

typedef GAS unsigned gu32;
#define RLX_AGENT __ATOMIC_RELAXED, __HIP_MEMORY_SCOPE_AGENT
#define PHASE_IDS() int tid_ = threadIdx.x; asm volatile("" : "+v"(tid_)); const int tid = tid_, lane = tid & 63, wid = __builtin_amdgcn_readfirstlane(tid >> 6); (void)tid; (void)lane; (void)wid; (void)0

#define XB_TMO      128
#define XB_XCNT(j)  (256  + 64 * (j))
#define XB_XSUB(j)  (1280 + 64 * (j))
#define XB_XGEN(j)  (2304 + 64 * (j))
#define XB_TOP      3328
#define XB_TOPGEN   3392
#define XCD_BAR_WORDS 3456
#define XB_SPIN_CAP (1u << 27)
__device__ __forceinline__ unsigned xb_ld(unsigned* p)              { return __hip_atomic_load(p, __ATOMIC_RELAXED, __HIP_MEMORY_SCOPE_AGENT); }
__device__ __forceinline__ unsigned xb_add(unsigned* p, unsigned v) { return __hip_atomic_fetch_add(p, v, __ATOMIC_RELAXED, __HIP_MEMORY_SCOPE_AGENT); }
__device__ __forceinline__ unsigned xb_xcc_id() { return (unsigned)__builtin_amdgcn_s_getreg((3 << 11) | 20) & 0xFu; }
#define XB_SPIN(cond, bar) do { unsigned _sp = 0; while (cond) { __builtin_amdgcn_s_sleep(1); \
    if ((++_sp & 255u) == 0u) { if (xb_ld(&(bar)[XB_TMO])) break; if (_sp > XB_SPIN_CAP) { atomicAdd(&(bar)[XB_TMO], 1u); break; } } } } while (0)
struct XcdBarrier { unsigned* bar; unsigned x; volatile LAS unsigned* st; };
__device__ __forceinline__ XcdBarrier xcd_barrier_post(unsigned* bar, volatile LAS unsigned* st) {
    XcdBarrier b; b.bar = bar; b.x = (unsigned)__builtin_amdgcn_readfirstlane((int)xb_xcc_id()); b.st = st;
    if (threadIdx.x == 0) (void)xb_add(&bar[XB_XCNT(b.x)], 1u);
    return b;
}
__device__ __forceinline__ void xcd_barrier_complete(unsigned* bar, unsigned x, unsigned& nloc, unsigned& nx) {
    const unsigned G = gridDim.x * gridDim.y * gridDim.z;
    unsigned sum, cnt, mine, sp = 0u;
    for (;;) {
        sum = 0u; cnt = 0u; mine = 0u;
#pragma unroll
        for (unsigned j = 0; j < 16; ++j) { const unsigned c = xb_ld(&bar[XB_XCNT(j)]); sum += c; cnt += (c > 0u) ? 1u : 0u; }
        if (sum == G) { mine = xb_ld(&bar[XB_XCNT(x)]); break; }
        __builtin_amdgcn_s_sleep(1);
        if ((++sp & 255u) == 0u) { if (xb_ld(&bar[XB_TMO])) break; if (sp > XB_SPIN_CAP) { atomicAdd(&bar[XB_TMO], 1u); break; } }
    }
    nloc = mine > 0u ? mine : 1u; nx = cnt > 0u ? cnt : 1u;
}
__device__ __forceinline__ void xcd_barrier(const XcdBarrier& b) {
    asm volatile("s_waitcnt vmcnt(0)" ::: "memory");
    __syncthreads();
    if (threadIdx.x == 0) {
        unsigned* bar = b.bar; unsigned bxx = b.x; asm volatile("" : "+s"(bar), "+s"(bxx));
        __builtin_amdgcn_s_waitcnt(0);
        unsigned nloc = b.st[0], nx = b.st[1];
        if (nloc == 0u) { xcd_barrier_complete(bar, bxx, nloc, nx); b.st[0] = nloc; b.st[1] = nx; }
        const unsigned old = xb_add(&bar[XB_XSUB(bxx)], 1u);
        const unsigned gen = old / nloc;
        if (old + 1u == (gen + 1u) * nloc) {
            __builtin_amdgcn_fence(__ATOMIC_RELEASE, "agent");
            asm volatile("s_waitcnt vmcnt(0)" ::: "memory");
            const unsigned og = xb_add(&bar[XB_TOP], 1u);
            const unsigned tg = og / nx;
            if (og + 1u == (tg + 1u) * nx) xb_add(&bar[XB_TOPGEN], 1u);
            else XB_SPIN(xb_ld(&bar[XB_TOPGEN]) == tg, bar);
            __builtin_amdgcn_fence(__ATOMIC_ACQUIRE, "agent");
            xb_add(&bar[XB_XGEN(bxx)], 1u);
            asm volatile("s_waitcnt vmcnt(0)" ::: "memory");
        } else {
            XB_SPIN(xb_ld(&bar[XB_XGEN(bxx)]) == gen, bar);
            __builtin_amdgcn_fence(__ATOMIC_ACQUIRE, "agent");
            asm volatile("s_waitcnt vmcnt(0)" ::: "memory");
        }
    }
    __syncthreads();
}

struct Args { const float* in[30]; float* out; unsigned char* ws; };
struct Frame {
    LAS unsigned char* lds; int vcu, G; float* out; unsigned char* ws; unsigned char* ob;
};
__device__ __forceinline__ const float* inp(const Frame& F, int i) {
    const LAS unsigned* t = (const LAS unsigned*)(F.lds + INTAB_OFF) + 2 * i; const unsigned lo = __builtin_amdgcn_readfirstlane(t[0]), hi = __builtin_amdgcn_readfirstlane(t[1]);
    return (const float*)(((unsigned long long)hi << 32) | lo); }
__device__ __forceinline__ float wave_sum(float v) {
#pragma unroll
    for (int o = 1; o < 64; o <<= 1) v += __shfl_xor(v, o);
    return v;
}

__device__ __forceinline__ int rowmap(int mode, int t) {
    if (mode == 1) { const int th = t & 255, half = th >> 7, w = th & 127, i = w & 63, hi = w >> 6; return (t & ~255) + 8 * ((half << 4) + (i >> 2)) + 4 * hi + (i & 3); }
    if (mode == 2) { const int th = t & 63, half = th >> 5, w = th & 31, i = w & 15, hi = w >> 4; return (t & ~63) + 8 * ((half << 2) + (i >> 2)) + 4 * hi + (i & 3); }
    if (mode == 3) { const int isg = t >= DFF ? 1 : 0; const int tt = isg ? t - DFF : t; return 8 * (tt >> 2) + 4 * isg + (tt & 3); }
    return t;
}
__device__ __forceinline__ void transpose_item(const float* W, int K, int N, bf16_t* WT, int row_off, int mode, LAS float* scr, int item, int lane) {
    const int nblk = N / 64, kb = item / nblk, nb = item % nblk, k0 = 64 * kb, n0 = 64 * nb;
    const int c4 = lane & 15, rr = lane >> 4;
    f32x4 v[16];
    const float* src = W + (size_t)(k0 + rr) * N + n0 + 4 * c4;
#pragma unroll
    for (int i = 0; i < 16; ++i) v[i] = *(const f32x4*)(src + (size_t)(4 * i) * N);
#pragma unroll
    for (int i = 0; i < 16; ++i) { LAS float* d = scr + (4 * i + rr) * 65 + 4 * c4; d[0] = v[i][0]; d[1] = v[i][1]; d[2] = v[i][2]; d[3] = v[i][3]; }
    asm volatile("s_waitcnt lgkmcnt(0)" ::: "memory");
    const int c = lane & 7;
#pragma unroll
    for (int j = 0; j < 8; ++j) { const int n = (lane >> 3) + 8 * j; const LAS float* s = scr + (8 * c) * 65 + n;
        u32x4 o; o.x = cvtpk(s[0 * 65], s[1 * 65]); o.y = cvtpk(s[2 * 65], s[3 * 65]); o.z = cvtpk(s[4 * 65], s[5 * 65]); o.w = cvtpk(s[6 * 65], s[7 * 65]);
        *(u32x4*)(WT + (size_t)(row_off + rowmap(mode, n0 + n)) * K + k0 + 8 * c) = o; }
    asm volatile("s_waitcnt lgkmcnt(0)" ::: "memory");
}
struct TrJob { const float* W; int K, N; bf16_t* WT; int row_off, mode, nitems; };
template <int NJ> __device__ __forceinline__ void run_transposes(const TrJob (&jobs)[NJ], LAS float* scr, int gw, int NGW, int lane) {
    int total = 0;
#pragma unroll
    for (int j = 0; j < NJ; ++j) total += jobs[j].nitems;
    for (int it = gw; it < total; it += NGW) {
        int r = it;
#pragma unroll
        for (int j = 0; j < NJ; ++j) { if (r >= 0 && r < jobs[j].nitems) { transpose_item(jobs[j].W, jobs[j].K, jobs[j].N, jobs[j].WT, jobs[j].row_off, jobs[j].mode, scr, r, lane); } r -= jobs[j].nitems; }
    }
}

__device__ __forceinline__ void p0_prologue(Frame& F, bool dry = false) {
    PHASE_IDS();
    LAS float* scr = (LAS float*)(F.lds + wid * 16640);
    const int gw = F.vcu * NWAVES + wid, NGW = F.G * NWAVES;
    float* mod = (float*)(F.ws + CTL_MOD_B);
    { const float* cvp = inp(F, 6); const float* ccp = inp(F, 7); const float* wbase = inp(F, 8); const float* bbase = inp(F, 9);
    for (int it = gw; it < 1536; it += NGW) {
        const int kq = it & 7, jb = (it >> 3) % 96, l = it / 768, j0 = jb * 64; const float* W = wbase + ((size_t)l * 1024 + kq * 128) * 6144 + j0 + lane;
        float acc[9]; const float bias = kq == 0 ? bbase[l * 6144 + j0 + lane] : 0.0f;
#pragma unroll
        for (int mb = 0; mb < 9; ++mb) acc[mb] = bias;
#pragma unroll 1
        for (int kb = 0; kb < 2; ++kb) {
            float sreg[9];
#pragma unroll
            for (int mb = 0; mb < 9; ++mb) { const float cv = mb < 8 ? cvp[mb * 1024 + kq * 128 + kb * 64 + lane] : ccp[kq * 128 + kb * 64 + lane]; sreg[mb] = cv / (1.0f + expf(-cv)); }
            float wv[64];
#pragma unroll
            for (int kk = 0; kk < 64; ++kk) wv[kk] = W[(size_t)(kb * 64 + kk) * 6144];
#pragma unroll
            for (int kk = 0; kk < 64; ++kk) {
#pragma unroll
                for (int mb = 0; mb < 9; ++mb) acc[mb] += __uint_as_float(__builtin_amdgcn_readlane(__float_as_uint(sreg[mb]), kk)) * wv[kk]; }
        }
#pragma unroll
        for (int mb = 0; mb < 9; ++mb) { if (!dry) atomicAdd(mod + (l * 9 + mb) * 6144 + j0 + lane, acc[mb]); else asm volatile("" :: "v"(acc[mb])); }
    } }
    { float* z0 = (float*)(F.ws + WS_NST); for (int e = gw * 64 + lane; e < 3 * MROWS; e += NGW * 64) z0[e] = 0.0f;
      float* z1 = (float*)(F.ws + WS_CB); for (int e = gw * 64 + lane; e < CB_TOTAL; e += NGW * 64) z1[e] = 0.0f; }
    { float* tr = (float*)(F.ws + WS_TABR); float* ta = (float*)(F.ws + WS_TABA);
      for (int e = gw * 64 + lane; e < 4096 + 1024; e += NGW * 64) {
          if (e < 4096) { const int pos = e >> 6, i = e & 63; const float inv = powf(10000.0f, -(float)i / 64.0f); const float ang = (float)pos * inv; tr[2 * e] = cosf(ang); tr[2 * e + 1] = sinf(ang); }
          else { const int e2 = e - 4096, pos = e2 >> 4, i = e2 & 15; const float inv = powf(10000.0f, -(float)i / 16.0f); const float ang = (float)pos * inv; ta[2 * e2] = cosf(ang); ta[2 * e2 + 1] = sinf(ang); } } }
    { bf16_t* ck = (bf16_t*)(F.ws + WS_CK); bf16_t* cv = (bf16_t*)(F.ws + WS_CV);
      for (int e = (gw * 64 + lane) * 4; e < 524288; e += NGW * 64 * 4) {
          const f32x4 a = *(const f32x4*)(inp(F, 4) + e), b = *(const f32x4*)(inp(F, 5) + e);
          u32x2 wa = {cvtpk(a[0], a[1]), cvtpk(a[2], a[3])}, wb = {cvtpk(b[0], b[1]), cvtpk(b[2], b[3])};
          *(u32x2*)(ck + e) = wa; *(u32x2*)(cv + e) = wb; } }
    { bf16_t* w1t = (bf16_t*)(F.ob + OUT_W1T);
      const TrJob jobs[5] = { {inp(F, 12), 1024, 1024, w1t, 0, 1, 256}, {inp(F, 13), 1024, 1024, w1t, 1024, 1, 256}, {inp(F, 14), 1024, 2048, w1t, 2048, 0, 512},
                              {inp(F, 15), 1024, 2048, w1t, 4096, 0, 512}, {inp(F, 16), 1024, 2048, w1t, 6144, 0, 512} };
      run_transposes<5>(jobs, scr, gw, NGW, lane); }
}

__device__ __forceinline__ void bias_items(Frame& F, int gw, int NGW, int lane) {
    const float* modp = (const float*)(F.ws + CTL_MOD_B); float* cb = (float*)(F.ws + WS_CB);
    for (int it = gw; it < 1600; it += NGW) {
        int r = it; const float* W; int N, nblk; const float* sh; float* out; int ldo;
        if (r < 1408) { const int l = r / 704; r -= l * 704; W = inp(F, 25) + (size_t)l * 1024 * 5632; N = 5632; nblk = 88; sh = modp + (size_t)(l * 9) * 6144 + 3 * 1024; out = cb + (l ? CB_FFN1 : CB_FFN0); ldo = 5632; }
        else { r -= 1408; sh = modp + (size_t)9 * 6144; ldo = 1536;
            if (r < 128) { W = inp(F, 20); N = 1024; nblk = 16; out = cb + CB_QKV; }
            else if (r < 160) { r -= 128; W = inp(F, 21); N = 256; nblk = 4; out = cb + CB_QKV + 1024; }
            else { r -= 160; W = inp(F, 22); N = 256; nblk = 4; out = cb + CB_QKV + 1280; } }
        const int kq = r & 7, jb = r >> 3, j0 = jb * 64; (void)nblk;
        const float* Wp = W + (size_t)(kq * 128) * N + j0 + lane;
        float acc[9];
#pragma unroll
        for (int mb = 0; mb < 9; ++mb) acc[mb] = 0.0f;
#pragma unroll 1
        for (int kb = 0; kb < 2; ++kb) {
            float sreg[9];
#pragma unroll
            for (int mb = 0; mb < 9; ++mb) sreg[mb] = sh[mb * 6144 + kq * 128 + kb * 64 + lane];
            float wv[64];
#pragma unroll
            for (int kk = 0; kk < 64; ++kk) wv[kk] = Wp[(size_t)(kb * 64 + kk) * N];
#pragma unroll
            for (int kk = 0; kk < 64; ++kk) { const float wq = __uint_as_float(cvtpk(wv[kk], 0.f) << 16);
#pragma unroll
                for (int mb = 0; mb < 9; ++mb) acc[mb] += __uint_as_float(__builtin_amdgcn_readlane(__float_as_uint(sreg[mb]), kk)) * wq; }
        }
#pragma unroll
        for (int mb = 0; mb < 9; ++mb) atomicAdd(out + mb * ldo + j0 + lane, acc[mb]);
    }
}

__device__ __forceinline__ void modulate_rows(Frame& F, const float* xa, const float* xb, const float* g, const float* modl, int shc, int scc, bf16_t* Hout) {
    PHASE_IDS();
    const int gw = F.vcu * NWAVES + wid, NGW = F.G * NWAVES;
    for (int row0 = gw; row0 < MROWS; row0 += 2 * NGW) {
        const int row1 = row0 + NGW < MROWS ? row0 + NGW : row0;
        const float* s0p = row0 < NCTX ? xa + (size_t)row0 * 1024 : xb + (size_t)(row0 - NCTX) * 1024;
        const float* s1p = row1 < NCTX ? xa + (size_t)row1 * 1024 : xb + (size_t)(row1 - NCTX) * 1024;
        f32x4 v0[4], v1[4];
#pragma unroll
        for (int j = 0; j < 4; ++j) { v0[j] = *(const f32x4*)(s0p + 4 * (lane + 64 * j)); v1[j] = *(const f32x4*)(s1p + 4 * (lane + 64 * j)); }
#pragma unroll
        for (int rr = 0; rr < 2; ++rr) {
            const int row = rr ? row1 : row0; const int mb = row < NCTX ? 8 : ((row - NCTX) >> 11);
            float ss = 0.f;
#pragma unroll
            for (int j = 0; j < 4; ++j) { const f32x4 t = rr ? v1[j] : v0[j]; ss += (t[0] * t[0] + t[1] * t[1]) + (t[2] * t[2] + t[3] * t[3]); }
            const float rstd = 1.0f / sqrtf(wave_sum(ss) * (1.0f / 1024.0f) + EPSV);
            const float* sh = modl + mb * 6144 + shc * 1024; const float* sc = modl + mb * 6144 + scc * 1024;
            if (rr == 0 || row1 != row0) {
#pragma unroll
            for (int j = 0; j < 4; ++j) { const int col = 4 * (lane + 64 * j); const f32x4 gg = *(const f32x4*)(g + col), s1 = *(const f32x4*)(sc + col), s0 = *(const f32x4*)(sh + col);
                const f32x4 t = rr ? v1[j] : v0[j]; const f32x4 y = (t * rstd) * gg * (1.0f + s1) + s0; u32x2 w = {cvtpk(y[0], y[1]), cvtpk(y[2], y[3])}; *(u32x2*)(Hout + (size_t)row * 1024 + col) = w; } }
        }
    }
}
__device__ __forceinline__ void final_norm(Frame& F, const bf16_t* Xp, float* Yp, const float* g) {
    PHASE_IDS();
    const int gw = F.vcu * NWAVES + wid, NGW = F.G * NWAVES;
    for (int row0 = gw; row0 < MROWS; row0 += 2 * NGW) {
        const int row1 = row0 + NGW < MROWS ? row0 + NGW : row0;
        u32x4 w0[2], w1[2];
#pragma unroll
        for (int j = 0; j < 2; ++j) { w0[j] = *(const u32x4*)(Xp + (size_t)row0 * 1024 + 16 * lane + 8 * j); w1[j] = *(const u32x4*)(Xp + (size_t)row1 * 1024 + 16 * lane + 8 * j); }
#pragma unroll
        for (int rr = 0; rr < 2; ++rr) {
            float v[16];
#pragma unroll
            for (int j = 0; j < 2; ++j) { const u32x4 w = rr ? w1[j] : w0[j]; v[8 * j] = bflo(w.x); v[8 * j + 1] = bfhi(w.x); v[8 * j + 2] = bflo(w.y); v[8 * j + 3] = bfhi(w.y); v[8 * j + 4] = bflo(w.z); v[8 * j + 5] = bfhi(w.z); v[8 * j + 6] = bflo(w.w); v[8 * j + 7] = bfhi(w.w); }
            float ss = 0.f;
#pragma unroll
            for (int e = 0; e < 16; ++e) ss += v[e] * v[e];
            const float rstd = 1.0f / sqrtf(wave_sum(ss) * (1.0f / 1024.0f) + EPSV);
            if (rr == 0 || row1 != row0) { float* dst = Yp + (size_t)(rr ? row1 : row0) * 1024 + 16 * lane;
#pragma unroll
                for (int q = 0; q < 4; ++q) { const f32x4 gg = *(const f32x4*)(g + 16 * lane + 4 * q); *(f32x4*)(dst + 4 * q) = (f32x4){v[4 * q] * rstd * gg[0], v[4 * q + 1] * rstd * gg[1], v[4 * q + 2] * rstd * gg[2], v[4 * q + 3] * rstd * gg[3]}; } }
        }
    }
}

__device__ __forceinline__ s16x4 vtr(const LAS unsigned char* p) { return __builtin_bit_cast(s16x4, __builtin_amdgcn_ds_read_tr16_b64_v4i16((LAS v4i16_t*)p)); }
__device__ __forceinline__ bf16x8 cat8(s16x4 lo, s16x4 hi) { return __builtin_shufflevector(lo, hi, 0, 1, 2, 3, 4, 5, 6, 7); }
__device__ __forceinline__ bf16x8 pack8(const f32x16& x, int s) {
    u32x4 p; p.x = cvtpk(x[8 * s], x[8 * s + 1]); p.y = cvtpk(x[8 * s + 2], x[8 * s + 3]); p.z = cvtpk(x[8 * s + 4], x[8 * s + 5]); p.w = cvtpk(x[8 * s + 6], x[8 * s + 7]);
    return __builtin_bit_cast(bf16x8, p);
}
constexpr int RA = 0, RB = 32768, RC = 65536, RD = 98304;
#define RWAITV(n) asm volatile("s_waitcnt vmcnt(" #n ")" ::: "memory")
#define RBAR() do { asm volatile("s_waitcnt lgkmcnt(0)" ::: "memory"); __builtin_amdgcn_s_barrier(); asm volatile("" ::: "memory"); } while (0)
__device__ __forceinline__ void glds16(const void* gsrc, unsigned lds_dst) { unsigned keep;
    asm volatile("s_mov_b32 %0, m0\n\ts_mov_b32 m0, %2\n\ts_nop 0\n\tglobal_load_lds_dwordx4 %1, off\n\ts_mov_b32 m0, %0" : "=&s"(keep) : "v"(gsrc), "s"(lds_dst) : "memory"); }
#define RSTAGE(ldsoff, gptr, voff) do { _Pragma("unroll") for (int _i = 0; _i < 2; ++_i) \
    glds16((const char*)(gptr) + (voff)[_i], (unsigned)__builtin_amdgcn_readfirstlane((int)(lds0 + (ldsoff) + ldsw + _i * 8192))); } while (0)
__device__ __forceinline__ int dkl_of(int r, int h5) { const int q = r >> 2; return 16 * (q >> 1) + 8 * h5 + 4 * (q & 1) + (r & 3); }
__device__ __forceinline__ void retention_item3(Frame& F, int type, int b, int h, int dir, int sl, bool dry = false) {
    PHASE_IDS();
    const int g = wid >> 2, w = wid & 3;
    LAS unsigned char* L = F.lds;
    const bf16_t* Qg = (const bf16_t*)(F.ws + WS_Q); const bf16_t* Kg = (const bf16_t*)(F.ws + WS_K); const bf16_t* Vg = (const bf16_t*)(F.ws + WS_V);
    bf16_t* SG = dir ? (bf16_t*)(F.ob + OUT_SGB) : (bf16_t*)(F.ws + WS_SGF);
    float* stats = (float*)(F.ws + CTL_STATS_B);
    const int nch = type ? 16 : 2, rowbase = type ? NCTX + b * 2048 : b * 256;
    const float raw = (dir ? inp(F, 19) : inp(F, 18))[h];
    const float lg2_ = -log1pf(expf(-raw)) * LOG2E;
    const int jt = wid >> 1, it0 = 2 * (wid & 1);
    const unsigned ldsw = (unsigned)wid * 1024u; const unsigned lds0 = (unsigned)(uintptr_t)L;
    unsigned voffQ[2], voffV[2];
    { const int row = tid >> 3, xsr = (((row >> 1) & 1) << 2) | ((row >> 2) & 3), cs = (tid & 7) ^ xsr;
      voffQ[0] = (unsigned)(row * 1024 + 8 * cs) * 2u; voffQ[1] = voffQ[0] + 64u * 1024u * 2u; voffV[0] = (unsigned)(row * 2048 + 8 * cs) * 2u; voffV[1] = voffV[0] + 64u * 2048u * 2u; }
    f32x16 st[4];
    { const int n = lane & 31, h5 = lane >> 5;
      const float* S0 = (dir ? inp(F, 3) : inp(F, 2)) + (size_t)(b * 4 + h) * 256 * 512 + sl * 128 + 32 * w + n;
#pragma unroll
      for (int d = 0; d < 4; ++d)
#pragma unroll
          for (int r = 0; r < 16; ++r) st[d][r] = type ? S0[(size_t)(64 * d + 32 * g + dkl_of(r, h5)) * 512] : 0.0f; }
#define QSRC(c_, d_) ((const char*)(Qg + (size_t)(rowbase + 128 * (c_)) * 1024 + h * 256 + 64 * (d_)))
#define KSRC(c_, d_) ((const char*)(Kg + (size_t)(rowbase + 128 * (c_)) * 1024 + h * 256 + 64 * (d_)))
#define VSRC(c_, hv_) ((const char*)(Vg + (size_t)(rowbase + 128 * (c_)) * 2048 + h * 512 + sl * 128 + 64 * (hv_)))
    { const int c0 = dir ? nch - 1 : 0;
      asm volatile("s_waitcnt vmcnt(0) lgkmcnt(0)" ::: "memory"); __builtin_amdgcn_s_barrier();
      RSTAGE(RA, QSRC(c0, 0), voffQ); RSTAGE(RA + 16384, KSRC(c0, 0), voffQ); RSTAGE(RB, QSRC(c0, 1), voffQ); RSTAGE(RB + 16384, KSRC(c0, 1), voffQ);
      RSTAGE(RD, VSRC(c0, 0), voffV); RSTAGE(RD + 16384, VSRC(c0, 1), voffV);
      RWAITV(0); }
    for (int cc = 0; cc < nch; ++cc) {
        const int c = dir ? nch - 1 - cc : cc; const int R0 = rowbase + 128 * c;
        const int cn = cc + 1 < nch ? (dir ? c - 1 : c + 1) : c;
        int tl = tid; float lg2 = lg2_; asm volatile("" : "+v"(tl), "+v"(lg2));
        const int tid = tl, lane = tl & 63, n = lane & 31, h5 = lane >> 5, blk = (lane >> 4) & 1, q4 = (lane & 15) >> 2, p4 = lane & 3;
        const float g128 = __builtin_amdgcn_exp2f(lg2 * 128.0f);
        const int xn = (((n >> 1) & 1) << 2) | ((n >> 2) & 3), y16 = (xn ^ h5) << 4;
        int rs[4];
#pragma unroll
        for (int s = 0; s < 4; ++s) rs[s] = n * 128 + ((s << 5) ^ y16);
        const int rc[2] = {n * 128 + (((4 * g) << 4) ^ y16), n * 128 + (((4 * g + 2) << 4) ^ y16)};
        const int xr0 = (((q4 >> 1) & 1) << 2) | (2 * h5), xr1 = xr0 | 1;
        const int cV = 4 * (w & 1) + 2 * blk + (p4 >> 1), cK = 4 * g + 2 * blk + (p4 & 1);
        const int tv0 = (w >> 1) * 16384 + (8 * h5 + q4) * 128 + ((cV ^ xr0) << 4) + (p4 & 1) * 8, tv1 = (w >> 1) * 16384 + (8 * h5 + 4 + q4) * 128 + ((cV ^ xr1) << 4) + (p4 & 1) * 8;
        const int tk0 = (8 * h5 + q4) * 128 + ((cK ^ xr0) << 4) + (p4 >> 1) * 8, tk1 = (8 * h5 + 4 + q4) * 128 + ((cK ^ xr1) << 4) + (p4 >> 1) * 8;
        f32x16 oacc[4], X0, X1;
#pragma unroll
        for (int i = 0; i < 16; ++i) { oacc[0][i] = 0.f; oacc[1][i] = 0.f; oacc[2][i] = 0.f; oacc[3][i] = 0.f; X0[i] = 0.f; X1[i] = 0.f; }
#define LDQK(s_, BUF, A_, B0_, B1_) do { A_ = *(const LAS bf16x8*)(L + (BUF) + 16384 + 4096 * jt + rs[s_]); B0_ = *(const LAS bf16x8*)(L + (BUF) + 4096 * it0 + rs[s_]); B1_ = *(const LAS bf16x8*)(L + (BUF) + 4096 * (it0 + 1) + rs[s_]); } while (0)
#define LDCR(s_, BUF, C_) do { _Pragma("unroll") for (int it = 0; it < 4; ++it) C_[it] = *(const LAS bf16x8*)(L + (BUF) + 4096 * it + rc[s_]); } while (0)
#define R3_TILE1(d, BUF) do { bf16x8 a0, b00, b01, a1, b10, b11, cfr[4], dfr[4]; \
        LDQK(0, BUF, a0, b00, b01); LDQK(1, BUF, a1, b10, b11); \
        X0 = MFMA32(a0, b00, X0); X1 = MFMA32(a0, b01, X1); PINV(X0); PINV(X1); FENCE(); \
        LDQK(2, BUF, a0, b00, b01); \
        X0 = MFMA32(a1, b10, X0); X1 = MFMA32(a1, b11, X1); PINV(X0); PINV(X1); FENCE(); \
        LDQK(3, BUF, a1, b10, b11); LDCR(0, BUF, cfr); \
        X0 = MFMA32(a0, b00, X0); X1 = MFMA32(a0, b01, X1); PINV(X0); PINV(X1); FENCE(); \
        X0 = MFMA32(a1, b10, X0); X1 = MFMA32(a1, b11, X1); PINV(X0); PINV(X1); FENCE(); \
        LDCR(1, BUF, dfr); \
        { const bf16x8 bfr = pack8(st[d], 0); _Pragma("unroll") for (int it = 0; it < 4; ++it) oacc[it] = MFMA32(cfr[it], bfr, oacc[it]); } \
        PINV(oacc[0]); PINV(oacc[1]); PINV(oacc[2]); PINV(oacc[3]); FENCE(); \
        { const bf16x8 bfr = pack8(st[d], 1); _Pragma("unroll") for (int it = 0; it < 4; ++it) oacc[it] = MFMA32(dfr[it], bfr, oacc[it]); } \
        PINV(oacc[0]); PINV(oacc[1]); PINV(oacc[2]); PINV(oacc[3]); FENCE(); } while (0)
        RWAITV(8);
        RBAR();
        RSTAGE(RC, QSRC(c, 2), voffQ); RSTAGE(RC + 16384, KSRC(c, 2), voffQ);
        {
            const int hv = tid >> 8, bo = (tid & 255) * 64; const int R = bo >> 7;
            const float pj = (float)(dir ? 127 - R : R); const float zeta = __builtin_amdgcn_exp2f(lg2 * (127.0f - pj));
            LAS u32x4* vp = (LAS u32x4*)(L + RD + hv * 16384 + bo);
#pragma unroll
            for (int ii = 0; ii < 4; ++ii) { const u32x4 vv = vp[ii]; u32x4 z;
                z.x = cvtpk(bflo(vv.x) * zeta, bfhi(vv.x) * zeta); z.y = cvtpk(bflo(vv.y) * zeta, bfhi(vv.y) * zeta); z.z = cvtpk(bflo(vv.z) * zeta, bfhi(vv.z) * zeta); z.w = cvtpk(bflo(vv.w) * zeta, bfhi(vv.w) * zeta);
                vp[ii] = z; }
        }
        if (!(dry && (RET_ABL & 1))) R3_TILE1(0, RA);
        RWAITV(4); RBAR();
        RSTAGE(RA, QSRC(c, 3), voffQ); RSTAGE(RA + 16384, KSRC(c, 3), voffQ);
        if (!(dry && (RET_ABL & 1))) R3_TILE1(1, RB);
        RWAITV(4); RBAR();
        RSTAGE(RB + 16384, KSRC(c, 0), voffQ);
        if (!(dry && (RET_ABL & 1))) R3_TILE1(2, RC);
        RWAITV(2); RBAR();
        RSTAGE(RC + 16384, KSRC(c, 1), voffQ);
        if (!(dry && (RET_ABL & 1))) R3_TILE1(3, RA);
        { const float sg = dir ? -lg2 : lg2; const float e0 = dir ? (float)(128 - 4 * h5) : (float)(4 * h5 + 1);
          float fa[4], fb[4], fc[4], fbc[16];
#pragma unroll
          for (int q = 0; q < 4; ++q) { fa[q] = __builtin_amdgcn_exp2f(sg * (float)(32 * q)); fb[q] = __builtin_amdgcn_exp2f(sg * (float)(8 * q)); fc[q] = __builtin_amdgcn_exp2f(lg2 * e0 + sg * (float)q); }
#pragma unroll
          for (int r = 0; r < 16; ++r) fbc[r] = fb[r >> 2] * fc[r & 3];
#pragma unroll
          for (int it = 0; it < 4; ++it)
#pragma unroll
              for (int r = 0; r < 16; ++r) oacc[it][r] *= fa[it] * fbc[r]; }
        RBAR();
        RSTAGE(RB, KSRC(c, 2), voffQ); RSTAGE(RC, KSRC(c, 3), voffQ);
#pragma unroll
        for (int tt = 0; tt < 2; ++tt) {
            const int i = 32 * (it0 + tt) + n; const float ui = __builtin_amdgcn_exp2f(lg2 * (float)((dir ? 127 - i : i) - 127));
#pragma unroll
            for (int r4 = 0; r4 < 4; ++r4) { const int j0 = 32 * jt + 8 * r4 + 4 * h5; float vv[4];
#pragma unroll
                for (int e = 0; e < 4; ++e) { const int j = j0 + e; const int dd = dir ? j - i : i - j; const float x = tt ? X1[4 * r4 + e] : X0[4 * r4 + e]; vv[e] = dd >= 0 ? x * ui : 0.0f; }
                u32x2 wv = {cvtpk(vv[0], vv[1]), cvtpk(vv[2], vv[3])};
                *(LAS u32x2*)(L + RA + (jt >> 1) * 16384 + i * 128 + (((4 * (jt & 1) + r4) ^ xn) << 4) + 8 * h5) = wv; }
        }
#pragma unroll
        for (int d = 0; d < 4; ++d)
#pragma unroll
            for (int r = 0; r < 16; ++r) st[d][r] *= g128;
        RBAR();
        if (!(dry && (RET_ABL & 4))) {
            bf16x8 pf[2][4], vf[2];
#define LDIN(ks_, slot_) do { const LAS unsigned char* vb_ = L + RD + 8192 * g + 2048 * (ks_); vf[slot_] = cat8(vtr(vb_ + tv0), vtr(vb_ + tv1)); \
            _Pragma("unroll") for (int it = 0; it < 4; ++it) pf[slot_][it] = *(const LAS bf16x8*)(L + RA + 16384 * g + 4096 * it + rs[ks_]); } while (0)
            LDIN(0, 0);
#pragma unroll
            for (int ks = 0; ks < 4; ++ks) {
                if (ks < 3) { if (ks & 1) LDIN((ks + 1) & 3, 0); else LDIN((ks + 1) & 3, 1); }
#pragma unroll
                for (int it = 0; it < 4; ++it) oacc[it] = MFMA32(pf[ks & 1][it], vf[ks & 1], oacc[it]);
                PINV(oacc[0]); PINV(oacc[1]); PINV(oacc[2]); PINV(oacc[3]); FENCE();
            }
#undef LDIN
        }
        RWAITV(0); RBAR();
        RSTAGE(RA, QSRC(cn, 0), voffQ); RSTAGE(RA + 16384, KSRC(cn, 0), voffQ);
        const int cu = tid >> 4, cw2 = (tid >> 2) & 3, cnq = tid & 3;
        bf16_t* zp = SG + (size_t)(R0 + 4 * cu) * 2048 + h * 512 + sl * 128 + 32 * cw2 + 8 * cnq;
        u32x4 gv[4];
#pragma unroll
        for (int e = 0; e < 4; ++e) gv[e] = *(const u32x4*)(zp + (size_t)e * 2048);
        if (!(dry && (RET_ABL & 2))) {
            bf16x8 kf[2][4], zf[2];
#define LDST(ks_, slot_) do { const LAS unsigned char* zb_ = L + RD + 2048 * (ks_); zf[slot_] = cat8(vtr(zb_ + tv0), vtr(zb_ + tv1)); \
            kf[slot_][0] = cat8(vtr(L + RB + 16384 + 2048 * (ks_) + tk0), vtr(L + RB + 16384 + 2048 * (ks_) + tk1)); kf[slot_][1] = cat8(vtr(L + RC + 16384 + 2048 * (ks_) + tk0), vtr(L + RC + 16384 + 2048 * (ks_) + tk1)); \
            kf[slot_][2] = cat8(vtr(L + RB + 2048 * (ks_) + tk0), vtr(L + RB + 2048 * (ks_) + tk1)); kf[slot_][3] = cat8(vtr(L + RC + 2048 * (ks_) + tk0), vtr(L + RC + 2048 * (ks_) + tk1)); } while (0)
            LDST(0, 0);
#pragma unroll
            for (int ks = 0; ks < 8; ++ks) {
                if (ks < 7) { if (ks & 1) LDST((ks + 1) & 7, 0); else LDST((ks + 1) & 7, 1); }
#pragma unroll
                for (int d = 0; d < 4; ++d) st[d] = MFMA32(kf[ks & 1][d], zf[ks & 1], st[d]);
                PINV(st[0]); PINV(st[1]); PINV(st[2]); PINV(st[3]); FENCE();
            }
#undef LDST
        }
        RBAR();
        RSTAGE(RB, QSRC(cn, 1), voffQ); RSTAGE(RB + 16384, KSRC(cn, 1), voffQ);
        RSTAGE(RD, VSRC(cn, 0), voffV); RSTAGE(RD + 16384, VSRC(cn, 1), voffV);
        if (g == 1 && !(dry && (RET_ABL & 8))) {
#pragma unroll
            for (int it = 0; it < 4; ++it)
#pragma unroll
                for (int r4 = 0; r4 < 4; ++r4) { const int u = 8 * it + 2 * r4 + h5; u32x2 pk = {cvtpk(oacc[it][4 * r4], oacc[it][4 * r4 + 1]), cvtpk(oacc[it][4 * r4 + 2], oacc[it][4 * r4 + 3])};
                    *(LAS u32x2*)(L + RC + (w * 32 + n) * 256 + ((u ^ n ^ (w << 1)) << 3)) = pk; }
        }
        RBAR();
        if (g == 0 && !(dry && (RET_ABL & 8))) {
#pragma unroll
            for (int it = 0; it < 4; ++it)
#pragma unroll
                for (int r4 = 0; r4 < 4; ++r4) { const int u = 8 * it + 2 * r4 + h5; LAS u32x2* p = (LAS u32x2*)(L + RC + (w * 32 + n) * 256 + ((u ^ n ^ (w << 1)) << 3)); const u32x2 o = *p;
                    u32x2 pk = {cvtpk(bflo(o.x) + oacc[it][4 * r4], bfhi(o.x) + oacc[it][4 * r4 + 1]), cvtpk(bflo(o.y) + oacc[it][4 * r4 + 2], bfhi(o.y) + oacc[it][4 * r4 + 3])};
                    *p = pk; }
        }
        RBAR();
        {
          float o[4][8]; float ss[4] = {0.f, 0.f, 0.f, 0.f};
#pragma unroll
          for (int e = 0; e < 8; ++e) { const int nn = 8 * cnq + e; const u32x2 v2 = *(const LAS u32x2*)(L + RC + (cw2 * 32 + nn) * 256 + ((cu ^ nn ^ (cw2 << 1)) << 3));
              o[0][e] = bflo(v2.x); o[1][e] = bfhi(v2.x); o[2][e] = bflo(v2.y); o[3][e] = bfhi(v2.y); }
#pragma unroll
          for (int rr = 0; rr < 4; ++rr) {
#pragma unroll
              for (int e = 0; e < 8; ++e) ss[rr] += o[rr][e] * o[rr][e];
              ss[rr] += __shfl_xor(ss[rr], 1); ss[rr] += __shfl_xor(ss[rr], 2); ss[rr] += __shfl_xor(ss[rr], 4); ss[rr] += __shfl_xor(ss[rr], 8); }
          RWAITV(8);
          if ((tid & 15) == 0 && !dry) {
#pragma unroll
              for (int rr = 0; rr < 4; ++rr) atomicAdd(stats + ((size_t)(R0 + 4 * cu + rr) * 4 + h) * 2 + dir, ss[rr]); }
          if (!dry) {
#pragma unroll
              for (int rr = 0; rr < 4; ++rr) { const u32x4 gq = gv[rr]; u32x4 z;
                  z.x = cvtpk(o[rr][0] * bflo(gq.x), o[rr][1] * bfhi(gq.x)); z.y = cvtpk(o[rr][2] * bflo(gq.y), o[rr][3] * bfhi(gq.y));
                  z.z = cvtpk(o[rr][4] * bflo(gq.z), o[rr][5] * bfhi(gq.z)); z.w = cvtpk(o[rr][6] * bflo(gq.w), o[rr][7] * bfhi(gq.w));
                  *(u32x4*)(zp + (size_t)rr * 2048) = z; } }
          else { asm volatile("" :: "v"(gv[0]), "v"(gv[1]), "v"(gv[2]), "v"(gv[3])); } }
    }
    if (type == 0) {
        const int n = lane & 31, h5 = lane >> 5;
        float* So = (float*)(F.ob + (dir ? OUT_SB : OUT_SF)) + (size_t)(b * 4 + h) * 256 * 512 + sl * 128 + 32 * w + n;
#pragma unroll
        for (int d = 0; d < 4; ++d)
#pragma unroll
            for (int r = 0; r < 16; ++r) So[(size_t)(64 * d + 32 * g + dkl_of(r, h5)) * 512] = st[d][r];
    }
    asm volatile("s_waitcnt vmcnt(0) lgkmcnt(0)" ::: "memory");
#undef QSRC
#undef KSRC
#undef VSRC
#undef LDQK
#undef LDCR
#undef R3_TILE1
}
__device__ __forceinline__ void retention_phase(Frame& F, bool dry = false) {
    for (int it = F.vcu; it < 1280; it += F.G) {
        if (it < 256) retention_item3(F, 1, it >> 5, (it >> 3) & 3, (it >> 2) & 1, it & 3, dry);
        else { const int i2 = it - 256; retention_item3(F, 0, i2 >> 5, (i2 >> 3) & 3, (i2 >> 2) & 1, i2 & 3, dry); }
    }
}
__device__ __forceinline__ void combine_rows(Frame& F) {
    PHASE_IDS();
    const int gw = F.vcu * NWAVES + wid, NGW = F.G * NWAVES;
    const bf16_t* zf = (const bf16_t*)(F.ws + WS_SGF); const bf16_t* zb = (const bf16_t*)(F.ob + OUT_SGB); bf16_t* Y = (bf16_t*)(F.ws + WS_Y);
    const float* stats = (const float*)(F.ws + CTL_STATS_B);
    for (int row0 = gw; row0 < MROWS; row0 += 2 * NGW) {
        const int row1 = row0 + NGW < MROWS ? row0 + NGW : row0; const int h = lane >> 4;
        u32x4 a[2][4], c[2][4]; float sf[2], sb[2];
#pragma unroll
        for (int rr = 0; rr < 2; ++rr) { const int row = rr ? row1 : row0; const size_t off = (size_t)row * 2048 + lane * 32;
            sf[rr] = stats[((size_t)row * 4 + h) * 2]; sb[rr] = stats[((size_t)row * 4 + h) * 2 + 1];
#pragma unroll
            for (int e = 0; e < 4; ++e) { a[rr][e] = *(const u32x4*)(zf + off + 8 * e); c[rr][e] = *(const u32x4*)(zb + off + 8 * e); } }
#pragma unroll
        for (int rr = 0; rr < 2; ++rr) { const int row = rr ? row1 : row0; const size_t off = (size_t)row * 2048 + lane * 32;
            const float rf = 1.0f / sqrtf(sf[rr] * (1.0f / 512.0f) + EPSV), rb = 1.0f / sqrtf(sb[rr] * (1.0f / 512.0f) + EPSV);
            if (rr == 0 || row1 != row0) {
#pragma unroll
            for (int e = 0; e < 4; ++e) { const u32x4 p = a[rr][e], q = c[rr][e]; u32x4 y;
                y.x = cvtpk(rf * bflo(p.x) + rb * bflo(q.x), rf * bfhi(p.x) + rb * bfhi(q.x)); y.y = cvtpk(rf * bflo(p.y) + rb * bflo(q.y), rf * bfhi(p.y) + rb * bfhi(q.y));
                y.z = cvtpk(rf * bflo(p.z) + rb * bflo(q.z), rf * bfhi(p.z) + rb * bfhi(q.z)); y.w = cvtpk(rf * bflo(p.w) + rb * bflo(q.w), rf * bfhi(p.w) + rb * bfhi(q.w));
                *(u32x4*)(Y + off + 8 * e) = y; } }
        }
    }
}

constexpr int A2_K = 0, A2_V = 24576, A2_WS = 49152, A2_OST = 53248;
__device__ __forceinline__ void attn_item2(Frame& F, int type, int b, int kh, int qb, int abl = 0) {
    PHASE_IDS();
    const int n = lane & 31, h5 = lane >> 5, blk = (lane >> 4) & 1, q4 = (lane & 15) >> 2, p4 = lane & 3;
    LAS unsigned char* L = F.lds; LAS float* wsf = (LAS float*)(L + A2_WS) + wid * 32;
    const unsigned lds0 = (unsigned)(uintptr_t)L;
    const bf16_t* AQ = (const bf16_t*)(F.ws + WS_AQ); const bf16_t* AK = (const bf16_t*)(F.ws + WS_AK); const bf16_t* AV = (const bf16_t*)(F.ws + WS_AV);
    const bf16_t* CK = (const bf16_t*)(F.ws + WS_CK); const bf16_t* CV = (const bf16_t*)(F.ws + WS_CV); bf16_t* AO = (bf16_t*)(F.ws + WS_AO);
    const int gq = wid >> 1, rh = wid & 1, head = kh * 4 + gq;
    const int seq0 = type ? NCTX + b * 2048 : b * 256; const int qrow0 = seq0 + 64 * qb;
    int blo = 0, bhi = -1;
    if (type) { blo = qb - 2 < 0 ? 0 : qb - 2; bhi = qb + 2 > 31 ? 31 : qb + 2; }
    const int ntile = 4 + (type ? bhi - blo + 1 : 0);
    const int drow = tid >> 3, dxs = (((drow >> 1) & 1) << 2) | ((drow >> 2) & 3);
    const unsigned dvoff = (unsigned)(drow * 256 + 8 * ((tid & 7) ^ dxs)) * 2u;
    const unsigned ldsw = (unsigned)wid * 1024u;
#define A2_SRC(t_, KP, VP) do { const int t2_ = (t_); const bool band_ = t2_ >= 4; const int kt_ = band_ ? blo + (t2_ - 4) : t2_; \
        if (type == 0) { KP = (const char*)(AK + (size_t)(seq0 + 64 * kt_) * 256 + kh * 64); VP = (const char*)(AV + (size_t)(seq0 + 64 * kt_) * 256 + kh * 64); } \
        else if (!band_) { KP = (const char*)(CK + (size_t)(b * 256 + 64 * kt_) * 256 + kh * 64); VP = (const char*)(CV + (size_t)(b * 256 + 64 * kt_) * 256 + kh * 64); } \
        else { KP = (const char*)(AK + (size_t)(seq0 + 64 * kt_) * 256 + kh * 64); VP = (const char*)(AV + (size_t)(seq0 + 64 * kt_) * 256 + kh * 64); } } while (0)
#define A2_ISSUE(t_) do { const char* kp_; const char* vp_; const int tt_ = (t_) < ntile ? (t_) : ntile - 1; A2_SRC(tt_, kp_, vp_); const int slot_ = (t_) % 3; \
        glds16(kp_ + dvoff, (unsigned)__builtin_amdgcn_readfirstlane((int)(lds0 + A2_K + slot_ * 8192 + ldsw))); \
        glds16(vp_ + dvoff, (unsigned)__builtin_amdgcn_readfirstlane((int)(lds0 + A2_V + slot_ * 8192 + ldsw))); } while (0)
    asm volatile("s_waitcnt vmcnt(0) lgkmcnt(0)" ::: "memory"); __builtin_amdgcn_s_barrier();
    A2_ISSUE(0); A2_ISSUE(1);
    bf16x8 qf[4];
#pragma unroll
    for (int s = 0; s < 4; ++s) qf[s] = *(const bf16x8*)(AQ + (size_t)(qrow0 + 32 * rh + n) * 1024 + head * 64 + 16 * s + 8 * h5);
    asm volatile("s_waitcnt vmcnt(0)" : "+v"(qf[0]), "+v"(qf[1]), "+v"(qf[2]), "+v"(qf[3]) :: "memory");
    float mrun = 0.f, lrun = 0.f; f32x16 o0, o1, negm;
#pragma unroll
    for (int i = 0; i < 16; ++i) { o0[i] = 0.f; o1[i] = 0.f; negm[i] = 0.f; }
    const int xn = (((n >> 1) & 1) << 2) | ((n >> 2) & 3), y16 = (xn ^ h5) << 4;
    int rs[4];
#pragma unroll
    for (int s = 0; s < 4; ++s) rs[s] = n * 128 + ((s << 5) ^ y16);
    const int xlo = (((q4 >> 1) & 1) << 2) | h5, xhi = xlo | 2;
    int tvl[2], tvh[2];
#pragma unroll
    for (int c = 0; c < 2; ++c) { const int ch = 4 * c + 2 * blk + (p4 >> 1); tvl[c] = (4 * h5 + q4) * 128 + ((ch ^ xlo) << 4) + (p4 & 1) * 8; tvh[c] = (8 + 4 * h5 + q4) * 128 + ((ch ^ xhi) << 4) + (p4 & 1) * 8; }
    const float sink2 = inp(F, 24)[head] * LOG2E;
    for (int t = 0; t < ntile; ++t) {
        const bool band = t >= 4; const int kt = band ? blo + (t - 4) : t; const int slot = t % 3;
        asm volatile("s_waitcnt vmcnt(2)" ::: "memory"); RBAR();
        A2_ISSUE(t + 2);
        if (abl & 1) continue;
        const LAS unsigned char* Kt = L + A2_K + slot * 8192; const LAS unsigned char* Vt = L + A2_V + slot * 8192;
        f32x16 p0 = negm, p1 = negm;
#pragma unroll
        for (int s = 0; s < 4; ++s) {
            const bf16x8 a0 = *(const LAS bf16x8*)(Kt + rs[s]), a1 = *(const LAS bf16x8*)(Kt + 4096 + rs[s]);
            p0 = MFMA32(a0, qf[s], p0); p1 = MFMA32(a1, qf[s], p1);
        }
        if (band && (kt == qb - 2 || kt == qb + 2)) { const int qp = 64 * qb + 32 * rh + n;
#pragma unroll
            for (int r = 0; r < 16; ++r) { const int kp = 64 * kt + crow(r, h5); int d0 = qp - kp; d0 = d0 < 0 ? -d0 : d0; int d1 = qp - kp - 32; d1 = d1 < 0 ? -d1 : d1;
                if (d0 > 128) p0[r] = -1e30f; if (d1 > 128) p1[r] = -1e30f; } }
        float mx = __builtin_fmaxf(__builtin_fmaxf(p0[0], p0[1]), p1[0]), mx2 = __builtin_fmaxf(__builtin_fmaxf(p0[2], p0[3]), p1[1]);
        mx = __builtin_fmaxf(__builtin_fmaxf(mx, p1[2]), p1[3]);
#pragma unroll
        for (int r = 4; r < 16; r += 4) { mx = __builtin_fmaxf(__builtin_fmaxf(mx, p0[r]), p0[r + 1]); mx2 = __builtin_fmaxf(__builtin_fmaxf(mx2, p0[r + 2]), p0[r + 3]);
            mx = __builtin_fmaxf(__builtin_fmaxf(mx, p1[r]), p1[r + 1]); mx2 = __builtin_fmaxf(__builtin_fmaxf(mx2, p1[r + 2]), p1[r + 3]); }
        mx = __builtin_fmaxf(mx, mx2);
        mx = __builtin_fmaxf(mx, __shfl_xor(mx, 32));
        const bool resc = (t == 0) || __any(mx > 8.0f);
        float f = 1.0f;
        if (resc) { const float dl = (t == 0) ? mx : __builtin_fmaxf(mx, 0.0f); mrun = (t == 0) ? dl : mrun + dl; f = (t == 0) ? 0.0f : __builtin_amdgcn_exp2f(-dl);
#pragma unroll
            for (int r = 0; r < 16; ++r) { p0[r] -= dl; p1[r] -= dl; negm[r] = -mrun; } }
        float ls = 0.f;
#pragma unroll
        for (int r = 0; r < 16; ++r) { p0[r] = __builtin_amdgcn_exp2f(p0[r]); p1[r] = __builtin_amdgcn_exp2f(p1[r]); ls += p0[r] + p1[r]; }
        ls += __shfl_xor(ls, 32);
        lrun = lrun * f + ls;
        if (resc) {
            if (h5 == 0) wsf[n] = f;
            asm volatile("s_waitcnt lgkmcnt(0)" ::: "memory");
#pragma unroll
            for (int r = 0; r < 16; ++r) { const float fr_ = wsf[crow(r, h5)]; o0[r] *= fr_; o1[r] *= fr_; }
            asm volatile("s_waitcnt lgkmcnt(0)" ::: "memory");
        }
#pragma unroll
        for (int tk = 0; tk < 2; ++tk)
#pragma unroll
            for (int s = 0; s < 2; ++s) {
                const bf16x8 af = tk ? pack8(p1, s) : pack8(p0, s);
                const LAS unsigned char* vb = Vt + (32 * tk + 16 * s) * 128;
                o0 = MFMA32(af, cat8(vtr(vb + tvl[0]), vtr(vb + tvh[0])), o0);
                o1 = MFMA32(af, cat8(vtr(vb + tvl[1]), vtr(vb + tvh[1])), o1);
            }
    }
    lrun += __builtin_amdgcn_exp2f(sink2 - mrun);
    const float inv = 1.0f / lrun;
    if (h5 == 0) wsf[n] = inv;
    asm volatile("s_waitcnt lgkmcnt(0)" ::: "memory");
    { LAS bf16_t* stg = (LAS bf16_t*)(L + A2_OST) + wid * 2048;
#pragma unroll
      for (int r = 0; r < 16; ++r) { const float iv = wsf[crow(r, h5)]; const int orow = crow(r, h5);
          stg[orow * 64 + n] = (bf16_t)(cvtpk(o0[r] * iv, 0.f) & 0xffffu); stg[orow * 64 + 32 + n] = (bf16_t)(cvtpk(o1[r] * iv, 0.f) & 0xffffu); }
      asm volatile("s_waitcnt lgkmcnt(0)" ::: "memory");
      if (!(abl & 2)) {
#pragma unroll
          for (int i = 0; i < 4; ++i) { const int row = i * 8 + (lane >> 3), ch = lane & 7; const u32x4 v = *(const LAS u32x4*)(stg + row * 64 + ch * 8);
              *(u32x4*)(AO + (size_t)(qrow0 + 32 * rh + row) * 1024 + head * 64 + ch * 8) = v; } } }
    asm volatile("s_waitcnt vmcnt(0) lgkmcnt(0)" ::: "memory");
#undef A2_SRC
#undef A2_ISSUE
}
constexpr int A3_K = 0, A3_V = 32768, A3_WS = 65536, A3_OST = 69632;
__device__ __forceinline__ void attn_item3(Frame& F, int type, int b, int kh, int qb, int abl = 0) {
    PHASE_IDS();
    const int n = lane & 31, h5 = lane >> 5, blk = (lane >> 4) & 1, q4 = (lane & 15) >> 2, p4 = lane & 3;
    LAS unsigned char* L = F.lds; LAS float* wsf = (LAS float*)(L + A3_WS) + wid * 32;
    const unsigned lds0 = (unsigned)(uintptr_t)L;
    const bf16_t* AQ = (const bf16_t*)(F.ws + WS_AQ); const bf16_t* AK = (const bf16_t*)(F.ws + WS_AK); const bf16_t* AV = (const bf16_t*)(F.ws + WS_AV);
    const bf16_t* CK = (const bf16_t*)(F.ws + WS_CK); const bf16_t* CV = (const bf16_t*)(F.ws + WS_CV); bf16_t* AO = (bf16_t*)(F.ws + WS_AO);
    const int gq = wid >> 1, rh = wid & 1, head = kh * 4 + gq;
    const int seq0 = type ? NCTX + b * 2048 : b * 256; const int qrow0 = seq0 + 64 * qb;
    int blo = 0, bhi = -1;
    if (type) { blo = qb - 2 < 0 ? 0 : qb - 2; bhi = qb + 2 > 31 ? 31 : qb + 2; }
    const int ntile = 4 + (type ? bhi - blo + 1 : 0);
    const int drow = tid >> 3, dxs = (((drow >> 1) & 1) << 2) | ((drow >> 2) & 3);
    const unsigned dvoff = (unsigned)(drow * 256 + 8 * ((tid & 7) ^ dxs)) * 2u;
    const unsigned ldsw = (unsigned)wid * 1024u;
#define A2_SRC(t_, KP, VP) do { const int t2_ = (t_); const bool band_ = t2_ >= 4; const int kt_ = band_ ? blo + (t2_ - 4) : t2_; \
        if (type == 0) { KP = (const char*)(AK + (size_t)(seq0 + 64 * kt_) * 256 + kh * 64); VP = (const char*)(AV + (size_t)(seq0 + 64 * kt_) * 256 + kh * 64); } \
        else if (!band_) { KP = (const char*)(CK + (size_t)(b * 256 + 64 * kt_) * 256 + kh * 64); VP = (const char*)(CV + (size_t)(b * 256 + 64 * kt_) * 256 + kh * 64); } \
        else { KP = (const char*)(AK + (size_t)(seq0 + 64 * kt_) * 256 + kh * 64); VP = (const char*)(AV + (size_t)(seq0 + 64 * kt_) * 256 + kh * 64); } } while (0)
#define A2_ISSUE(t_) do { const char* kp_; const char* vp_; const int tt_ = (t_) < ntile ? (t_) : ntile - 1; A2_SRC(tt_, kp_, vp_); const int slot_ = (t_) & 3; \
        glds16(kp_ + dvoff, (unsigned)__builtin_amdgcn_readfirstlane((int)(lds0 + A3_K + slot_ * 8192 + ldsw))); \
        glds16(vp_ + dvoff, (unsigned)__builtin_amdgcn_readfirstlane((int)(lds0 + A3_V + slot_ * 8192 + ldsw))); } while (0)
    asm volatile("s_waitcnt vmcnt(0) lgkmcnt(0)" ::: "memory"); __builtin_amdgcn_s_barrier();
    A2_ISSUE(0); A2_ISSUE(1); A2_ISSUE(2);
    bf16x8 qf[4];
#pragma unroll
    for (int s = 0; s < 4; ++s) qf[s] = *(const bf16x8*)(AQ + (size_t)(qrow0 + 32 * rh + n) * 1024 + head * 64 + 16 * s + 8 * h5);
    asm volatile("s_waitcnt vmcnt(0)" : "+v"(qf[0]), "+v"(qf[1]), "+v"(qf[2]), "+v"(qf[3]) :: "memory");
    float mrun = 0.f, lrun = 0.f; f32x16 o0, o1, negm;
#pragma unroll
    for (int i = 0; i < 16; ++i) { o0[i] = 0.f; o1[i] = 0.f; negm[i] = 0.f; }
    const int xn = (((n >> 1) & 1) << 2) | ((n >> 2) & 3), y16 = (xn ^ h5) << 4;
    int rs[4];
#pragma unroll
    for (int s = 0; s < 4; ++s) rs[s] = n * 128 + ((s << 5) ^ y16);
    const int xlo = (((q4 >> 1) & 1) << 2) | h5, xhi = xlo | 2;
    int tvl[2], tvh[2];
#pragma unroll
    for (int c = 0; c < 2; ++c) { const int ch = 4 * c + 2 * blk + (p4 >> 1); tvl[c] = (4 * h5 + q4) * 128 + ((ch ^ xlo) << 4) + (p4 & 1) * 8; tvh[c] = (8 + 4 * h5 + q4) * 128 + ((ch ^ xhi) << 4) + (p4 & 1) * 8; }
    const float sink2 = inp(F, 24)[head] * LOG2E;
#define A3_QK(P0_, P1_, slot_) do { const LAS unsigned char* Kt_ = L + A3_K + (slot_) * 8192; P0_ = negm; P1_ = negm; \
        _Pragma("unroll") for (int s = 0; s < 4; ++s) { const bf16x8 a0 = *(const LAS bf16x8*)(Kt_ + rs[s]), a1 = *(const LAS bf16x8*)(Kt_ + 4096 + rs[s]); \
            P0_ = MFMA32(a0, qf[s], P0_); P1_ = MFMA32(a1, qf[s], P1_); } } while (0)
    f32x16 p0, p1, n0, n1;
    RBAR();
    A3_QK(p0, p1, 0);
    for (int t = 0; t < ntile; ++t) {
        const bool band = t >= 4; const int kt = band ? blo + (t - 4) : t; const int slot = t & 3; const bool has_next = t + 1 < ntile;
        asm volatile("s_waitcnt vmcnt(2)" ::: "memory"); RBAR();
        A2_ISSUE(t + 3);
        if (abl & 1) continue;
        const LAS unsigned char* Vt = L + A3_V + slot * 8192;
        if (has_next) A3_QK(n0, n1, (t + 1) & 3); else { n0 = negm; n1 = negm; }
        if (band && (kt == qb - 2 || kt == qb + 2)) { const int qp = 64 * qb + 32 * rh + n;
#pragma unroll
            for (int r = 0; r < 16; ++r) { const int kp = 64 * kt + crow(r, h5); int d0 = qp - kp; d0 = d0 < 0 ? -d0 : d0; int d1 = qp - kp - 32; d1 = d1 < 0 ? -d1 : d1;
                if (d0 > 128) p0[r] = -1e30f; if (d1 > 128) p1[r] = -1e30f; } }
        float mx = __builtin_fmaxf(__builtin_fmaxf(p0[0], p0[1]), p1[0]), mx2 = __builtin_fmaxf(__builtin_fmaxf(p0[2], p0[3]), p1[1]);
        mx = __builtin_fmaxf(__builtin_fmaxf(mx, p1[2]), p1[3]);
#pragma unroll
        for (int r = 4; r < 16; r += 4) { mx = __builtin_fmaxf(__builtin_fmaxf(mx, p0[r]), p0[r + 1]); mx2 = __builtin_fmaxf(__builtin_fmaxf(mx2, p0[r + 2]), p0[r + 3]);
            mx = __builtin_fmaxf(__builtin_fmaxf(mx, p1[r]), p1[r + 1]); mx2 = __builtin_fmaxf(__builtin_fmaxf(mx2, p1[r + 2]), p1[r + 3]); }
        mx = __builtin_fmaxf(mx, mx2);
        mx = __builtin_fmaxf(mx, __shfl_xor(mx, 32));
        const bool resc = (t == 0) || __any(mx > 8.0f);
        float f = 1.0f;
        if (resc) { const float dl = (t == 0) ? mx : __builtin_fmaxf(mx, 0.0f); mrun = (t == 0) ? dl : mrun + dl; f = (t == 0) ? 0.0f : __builtin_amdgcn_exp2f(-dl);
#pragma unroll
            for (int r = 0; r < 16; ++r) { p0[r] -= dl; p1[r] -= dl; n0[r] -= dl; n1[r] -= dl; negm[r] = -mrun; } }
        float ls = 0.f;
#pragma unroll
        for (int r = 0; r < 16; ++r) { p0[r] = __builtin_amdgcn_exp2f(p0[r]); p1[r] = __builtin_amdgcn_exp2f(p1[r]); ls += p0[r] + p1[r]; }
        ls += __shfl_xor(ls, 32);
        lrun = lrun * f + ls;
        if (resc) {
            if (h5 == 0) wsf[n] = f;
            asm volatile("s_waitcnt lgkmcnt(0)" ::: "memory");
#pragma unroll
            for (int r = 0; r < 16; ++r) { const float fr_ = wsf[crow(r, h5)]; o0[r] *= fr_; o1[r] *= fr_; }
            asm volatile("s_waitcnt lgkmcnt(0)" ::: "memory");
        }
#pragma unroll
        for (int tk = 0; tk < 2; ++tk)
#pragma unroll
            for (int s = 0; s < 2; ++s) {
                const bf16x8 af = tk ? pack8(p1, s) : pack8(p0, s);
                const LAS unsigned char* vb = Vt + (32 * tk + 16 * s) * 128;
                o0 = MFMA32(af, cat8(vtr(vb + tvl[0]), vtr(vb + tvh[0])), o0);
                o1 = MFMA32(af, cat8(vtr(vb + tvl[1]), vtr(vb + tvh[1])), o1);
            }
        p0 = n0; p1 = n1;
    }
    lrun += __builtin_amdgcn_exp2f(sink2 - mrun);
    const float inv = 1.0f / lrun;
    if (h5 == 0) wsf[n] = inv;
    asm volatile("s_waitcnt lgkmcnt(0)" ::: "memory");
    { LAS bf16_t* stg = (LAS bf16_t*)(L + A3_OST) + wid * 2048;
#pragma unroll
      for (int r = 0; r < 16; ++r) { const float iv = wsf[crow(r, h5)]; const int orow = crow(r, h5);
          stg[orow * 64 + n] = (bf16_t)(cvtpk(o0[r] * iv, 0.f) & 0xffffu); stg[orow * 64 + 32 + n] = (bf16_t)(cvtpk(o1[r] * iv, 0.f) & 0xffffu); }
      asm volatile("s_waitcnt lgkmcnt(0)" ::: "memory");
      if (!(abl & 2)) {
#pragma unroll
          for (int i = 0; i < 4; ++i) { const int row = i * 8 + (lane >> 3), ch = lane & 7; const u32x4 v = *(const LAS u32x4*)(stg + row * 64 + ch * 8);
              *(u32x4*)(AO + (size_t)(qrow0 + 32 * rh + row) * 1024 + head * 64 + ch * 8) = v; } } }
    asm volatile("s_waitcnt vmcnt(0) lgkmcnt(0)" ::: "memory");
#undef A2_SRC
#undef A2_ISSUE
#undef A3_QK
}
__device__ __forceinline__ void attn_phase(Frame& F, int abl = 0) {
    for (int it = F.vcu; it < 1536; it += F.G) {
        if (it < 1024) attn_item3(F, 1, it >> 7, (it >> 5) & 3, it & 31, abl);
        else { const int i2 = it - 1024; attn_item3(F, 0, i2 >> 4, (i2 >> 2) & 3, i2 & 3, abl); }
    }
}

#define GRID_BAR() do { xcd_barrier(bar); asm volatile("" : "+s"(F.ws), "+s"(F.ob), "+s"(F.vcu), "+s"(F.G), "+s"(bx)); } while (0)
#define mod ((float*)(F.ws + CTL_MOD_B))
#define XS ((bf16_t*)F.ob)
#define X ((float*)F.ob)
#define H ((bf16_t*)(F.ws + WS_H))
template <int l>
__device__ __forceinline__ void layer_phases(Frame& F, const XcdBarrier& bar, int& bx) {
        const float* modl = mod + l * 9 * 6144;
        if (l == 1) {
            { pg8::Gemm g{H, (const bf16_t*)(F.ws + WS_WQKV), 1024}; pg8::TileOrder S; S.init(128, 6, F.G, bx, 0, 192);
              pg8::EpiAttnQKV E{(bf16_t*)(F.ws + WS_AQ), (bf16_t*)(F.ws + WS_AK), (bf16_t*)(F.ws + WS_AV), (float*)(F.ob + OUT_NK), (float*)(F.ob + OUT_NV), (const float*)(F.ws + WS_TABA), (const float*)(F.ws + WS_NST) + MROWS, (const float*)(F.ws + WS_CB) + CB_QKV};
              pg8::gemm_phase<3>(F.lds, g, S, E);
#if PROBE_DUP == 9
              GRID_BAR(); pg8::gemm_phase<3>(F.lds, g, S, E);
#endif
#if PROBE_DUP == 16
              GRID_BAR(); { pg8::EpiNull E0{(float*)(F.ws + WS_TABA)}; pg8::gemm_phase<3>(F.lds, g, S, E0); }
#endif
            }
            GRID_BAR();
#ifndef NO_ATTN
            attn_phase(F);
#endif
            GRID_BAR();
#if PROBE_DUP == 3
            attn_phase(F, ATT_ABL | 2); GRID_BAR();
#endif
            { pg8::Gemm g{(const bf16_t*)(F.ws + WS_AO), (const bf16_t*)(F.ws + WS_WOA), 1024}; pg8::TileOrder S; S.init(128, 4, F.G, bx, 0, 192);
              pg8::EpiResidT<false> E{nullptr, nullptr, XS, XS, modl + 2 * 1024, H, inp(F, 11) + 1024, modl + 4 * 1024, (float*)(F.ws + WS_NST) + 2 * MROWS, 0};
              pg8::gemm_phase<3>(F.lds, g, S, E);
#if PROBE_DUP == 11
              GRID_BAR(); { pg8::EpiResidT<false> E2 = E; E2.dry = 1; pg8::gemm_phase<3>(F.lds, g, S, E2); }
#endif
            }
            GRID_BAR();
        }
        { pg8::Gemm g{H, (const bf16_t*)(F.ws + (l ? WS_WIN1 : WS_WIN0)), 1024}; pg8::TileOrder S; S.init(104, 22, F.G, bx, 1);
          pg8::EpiFfn E{(bf16_t*)(F.ws + WS_ACT), inp(F, 26) + (size_t)l * 3 * 5632, inp(F, 27) + (size_t)l * 5632, (LAS float*)(F.lds + XCH_OFF), (const float*)(F.ws + WS_NST) + (l ? 2 * MROWS : 0), (const float*)(F.ws + WS_CB) + (l ? CB_FFN1 : CB_FFN0), 0};
#ifndef NO_FFN
          pg8::gemm_phase<4>(F.lds, g, S, E, STG2);
#endif
#if PROBE_DUP == 7
          if (l == 0) { GRID_BAR(); pg8::gemm_phase<4>(F.lds, g, S, E); }
#endif
#if PROBE_DUP == 18
          if (l == 0) { GRID_BAR(); pg8::EpiFfn E2 = E; E2.dry = 1; pg8::gemm_phase<4>(F.lds, g, S, E2); }
#endif
#if PROBE_DUP == 13
          if (l == 0) { GRID_BAR(); pg8::EpiNull E0{(float*)(F.ws + WS_TABA)}; pg8::gemm_phase<4>(F.lds, g, S, E0); }
#endif
        }
        GRID_BAR();
        { pg8::Gemm g{(const bf16_t*)(F.ws + WS_ACT), (const bf16_t*)(F.ws + (l ? WS_WOUT1 : WS_WOUT0)), 2816}; pg8::TileOrder S; S.init(128, 4, F.G, bx, 0, 192);
          pg8::EpiResidT<false> E{nullptr, nullptr, XS, l ? H : XS, modl + 5 * 1024, l ? (bf16_t*)nullptr : H, inp(F, 10) + 1024, mod + 9 * 6144 + 1 * 1024, (float*)(F.ws + WS_NST) + MROWS, 0};
          pg8::gemm_phase<3>(F.lds, g, S, E);
#if PROBE_DUP == 8
          if (l == 0) { GRID_BAR(); pg8::EpiResidT<false> E2 = E; E2.dry = 1; pg8::gemm_phase<3>(F.lds, g, S, E2); }
#endif
#if PROBE_DUP == 17
          if (l == 0) { GRID_BAR(); pg8::EpiNull E0{(float*)(F.ws + WS_TABA)}; pg8::gemm_phase<3>(F.lds, g, S, E0); }
#endif
        }
        GRID_BAR();
    }

__global__ void __launch_bounds__(NWAVES * 64, 2) mega_fwd(Args args) {
    extern __shared__ __attribute__((aligned(16))) unsigned char lds_raw[];
    Frame F;
    F.lds = (LAS unsigned char*)lds_raw;
    volatile LAS unsigned* MISC = (volatile LAS unsigned*)(F.lds + MISC_OFF);
    F.G = gridDim.x; { const int bx = blockIdx.x; F.vcu = (F.G % 8 == 0) ? (bx % 8) * (F.G / 8) + bx / 8 : bx; }
    F.out = args.out; F.ws = args.ws; F.ob = (unsigned char*)args.out;
    for (int u = threadIdx.x; u < (LDS_BYTES - LDSCTL_OFF) / 4; u += NWAVES * 64) ((LAS unsigned*)(F.lds + LDSCTL_OFF))[u] = 0u;
    __syncthreads();
    if (threadIdx.x == 0) {
#pragma unroll
        for (int i = 0; i < 30; ++i) ((LAS unsigned long long*)(F.lds + INTAB_OFF))[i] = (unsigned long long)args.in[i];
    }
    __syncthreads();
    XcdBarrier bar = xcd_barrier_post((unsigned*)(F.ws + CTL_BAR_B), MISC + 8);
    int bx = (int)blockIdx.x;

#ifndef NO_P0
    p0_prologue(F);
#endif
    GRID_BAR();
#if PROBE_DUP == 1
    p0_prologue(F, true); GRID_BAR();
#endif
    modulate_rows(F, inp(F, 0), inp(F, 1), inp(F, 10), mod, 0, 1, (bf16_t*)(F.ob + OUT_H0)); GRID_BAR();
#if PROBE_DUP == 19
    modulate_rows(F, inp(F, 0), inp(F, 1), inp(F, 10), mod, 0, 1, (bf16_t*)(F.ob + OUT_H0)); GRID_BAR();
#endif
    { pg8::Gemm g{(const bf16_t*)(F.ob + OUT_H0), (const bf16_t*)(F.ob + OUT_W1T), 1024}; pg8::TileOrder S; S.init(96, 32, F.G, bx, 0);
      pg8::EpiRet E{(bf16_t*)(F.ws + WS_Q), (bf16_t*)(F.ws + WS_K), (bf16_t*)(F.ws + WS_V), (bf16_t*)(F.ws + WS_SGF), (bf16_t*)(F.ob + OUT_SGB), (const float*)(F.ws + WS_TABR), 0, 0};
      pg8::gemm_phase<4>(F.lds, g, S, E, STG1);
#if PROBE_DUP == 6
      GRID_BAR(); pg8::gemm_phase<4>(F.lds, g, S, E);
#endif
#if PROBE_DUP == 14
      GRID_BAR(); { pg8::EpiRet E2 = E; E2.dry = 1; pg8::gemm_phase<4>(F.lds, g, S, E2); }
#endif
#if PROBE_DUP == 15
      GRID_BAR(); { pg8::EpiRet E2 = E; E2.dry = 1; E2.nosilu = 1; pg8::gemm_phase<4>(F.lds, g, S, E2); }
#endif
#if PROBE_DUP == 12
      GRID_BAR(); { pg8::EpiNull E0{(float*)(F.ws + WS_TABA)}; pg8::gemm_phase<4>(F.lds, g, S, E0); }
#endif
    }
    GRID_BAR();
#if PROBE_DUP == 2
    retention_phase(F, true); GRID_BAR();
#endif
#ifndef NO_RET
    retention_phase(F);
#endif
    GRID_BAR();
    for (int rep_ = 0; rep_ < (PROBE_DUP == 4 ? 2 : 1); ++rep_)
    { combine_rows(F);
      PHASE_IDS();
      LAS float* scr = (LAS float*)(F.lds + wid * 16640); const int gw = F.vcu * NWAVES + wid, NGW = F.G * NWAVES;
      bf16_t* wqkv = (bf16_t*)(F.ws + WS_WQKV);
      const TrJob jobs[10] = { {inp(F, 17), 2048, 1024, (bf16_t*)(F.ws + WS_WO_RET), 0, 0, 512},
                               {inp(F, 25), 1024, 5632, (bf16_t*)(F.ws + WS_WIN0), 0, 3, 1408}, {inp(F, 25) + (size_t)1024 * 5632, 1024, 5632, (bf16_t*)(F.ws + WS_WIN1), 0, 3, 1408},
                               {inp(F, 28), 2816, 1024, (bf16_t*)(F.ws + WS_WOUT0), 0, 0, 704}, {inp(F, 28) + (size_t)2816 * 1024, 2816, 1024, (bf16_t*)(F.ws + WS_WOUT1), 0, 0, 704},
                               {inp(F, 20), 1024, 1024, wqkv, 0, 2, 256}, {inp(F, 21), 1024, 256, wqkv, 1024, 2, 64}, {inp(F, 22), 1024, 256, wqkv, 1280, 0, 64},
                               {inp(F, 23), 1024, 1024, (bf16_t*)(F.ws + WS_WOA), 0, 0, 256}, {nullptr, 0, 64, nullptr, 0, 0, 0} };
#ifndef NO_P4T
      run_transposes<10>(jobs, scr, gw, NGW, lane);
#endif
      bias_items(F, gw, NGW, lane);
    }
    GRID_BAR();
    { pg8::Gemm g{(const bf16_t*)(F.ws + WS_Y), (const bf16_t*)(F.ws + WS_WO_RET), 2048}; pg8::TileOrder S; S.init(128, 4, F.G, bx, 0, 192);
      pg8::EpiResidT<true> E{inp(F, 0), inp(F, 1), nullptr, XS, mod + 2 * 1024, H, inp(F, 11), mod + 4 * 1024, (float*)(F.ws + WS_NST), 0};
      pg8::gemm_phase<3>(F.lds, g, S, E);
#if PROBE_DUP == 10
      GRID_BAR(); { pg8::EpiResidT<true> E2 = E; E2.dry = 1; pg8::gemm_phase<3>(F.lds, g, S, E2); }
#endif
    }
    GRID_BAR();
    layer_phases<0>(F, bar, bx);
    layer_phases<1>(F, bar, bx);
    final_norm(F, H, X, inp(F, 29));
}

extern "C" void kernel_launch(void* const* d_in, const int* in_sizes, int n_in, void* d_out, int out_size, void* d_ws, size_t ws_size, hipStream_t stream) {
    static int grid = 0;
    if (grid == 0) {
        if (n_in != 30 || out_size != 62914560 || ws_size < WS_NEED) { fprintf(stderr, "kernel_launch: unexpected problem: n_in %d out %d ws %zu (need %zu)\n", n_in, out_size, ws_size, (size_t)WS_NEED); grid = -1; return; }
        int dev = 0, cus = 0, per_cu = 0;
        if (hipGetDevice(&dev) != hipSuccess || hipDeviceGetAttribute(&cus, hipDeviceAttributeMultiprocessorCount, dev) != hipSuccess) { grid = -1; return; }
        if (hipFuncSetAttribute((const void*)mega_fwd, hipFuncAttributeMaxDynamicSharedMemorySize, LDS_BYTES) != hipSuccess) { fprintf(stderr, "kernel_launch: hipFuncSetAttribute failed\n"); grid = -1; return; }
        if (hipOccupancyMaxActiveBlocksPerMultiprocessor(&per_cu, (const void*)mega_fwd, NWAVES * 64, LDS_BYTES) != hipSuccess || per_cu < 1) { fprintf(stderr, "kernel_launch: occupancy query says %d\n", per_cu); per_cu = 1; }
        (void)hipGetLastError();
        grid = cus;
    }
    if (grid < 0) return;
    (void)hipMemsetAsync((char*)d_ws, 0, CTL_BYTES, stream);
    Args a{};
    for (int i = 0; i < 30; ++i) a.in[i] = (const float*)d_in[i];
    a.out = (float*)d_out; a.ws = (unsigned char*)d_ws;
    void* kargs[] = {&a};
    hipError_t e = hipLaunchCooperativeKernel((const void*)mega_fwd, dim3(grid), dim3(NWAVES * 64), kargs, LDS_BYTES, stream);
    if (e != hipSuccess) { (void)hipGetLastError(); fprintf(stderr, "kernel_launch: cooperative launch failed (%s); plain launch\n", hipGetErrorString(e));
        hipLaunchKernelGGL(mega_fwd, dim3(grid), dim3(NWAVES * 64), LDS_BYTES, stream, a); }
}
```
